# Optimizing an MI355X kernel written in HIP

```python
import jax, jax.numpy as jnp
from jax import lax
import numpy as np

D_MODEL = 2048
BATCH = 8
SEQ = 4096
DEPTH = 2

CHUNK = 64
Q_BLOCK = 128
HEAD_DIM = 128
ROPE_THETA = 500000.0
PARTIAL_ROPE_DIM = HEAD_DIM // 4
NORM_EPS = 1e-6
D_MIX = D_MODEL
D_FF = 5632
N_MOD = 9

A_HEADS = D_MIX // (4 * HEAD_DIM)
IDX_HEADS = 16
IDX_DIM = 64
TOPK_MAX = 256
B_HEADS = D_MIX // (2 * HEAD_DIM)
MLA_Q_RANK = 448
MLA_KV_RANK = 128
MLA_NOPE = 128
MLA_ROPE = 64
MLA_V = HEAD_DIM
C_HEADS = D_MIX // (4 * HEAD_DIM)

SPLIT_SIZES = (
    A_HEADS * HEAD_DIM, A_HEADS * HEAD_DIM, A_HEADS * HEAD_DIM,
    IDX_HEADS * IDX_DIM, IDX_DIM, IDX_HEADS,
    MLA_Q_RANK, MLA_KV_RANK, MLA_ROPE,
    C_HEADS * HEAD_DIM, C_HEADS * HEAD_DIM, C_HEADS * HEAD_DIM,
)
N_IN = sum(SPLIT_SIZES)

kernel_name = "hybrid_dsa_mla_stickbreaking_macaron_block"


def rms_norm(x, g):
    xf = x.astype(jnp.float32)
    y = xf * lax.rsqrt(jnp.mean(xf * xf, axis=-1, keepdims=True) + NORM_EPS)
    return (y * g.astype(jnp.float32)).astype(x.dtype)


def rope_tables(seq, dim):
    inv = 1.0 / (ROPE_THETA ** (jnp.arange(0, dim, 2, dtype=jnp.float32) / dim))
    ang = jnp.arange(seq, dtype=jnp.float32)[:, None] * inv[None, :]
    return jnp.cos(ang), jnp.sin(ang)


def apply_rope(x, cos, sin):
    x1, x2 = jnp.split(x, 2, axis=-1)
    c = cos[None, :, None, :].astype(x.dtype)
    s = sin[None, :, None, :].astype(x.dtype)
    return jnp.concatenate([x1 * c - x2 * s, x1 * s + x2 * c], axis=-1)


def partial_rope(x, cos, sin):
    r = PARTIAL_ROPE_DIM
    return jnp.concatenate([apply_rope(x[..., :r], cos, sin), x[..., r:]], axis=-1)


def chunk_mask(start, seq):
    q_pos = start + jnp.arange(Q_BLOCK)
    k_pos = jnp.arange(seq)
    return (k_pos[None, :] // CHUNK) <= (q_pos[:, None] // CHUNK)


def sweep_query_blocks(fn, *qs):
    b, s = qs[0].shape[:2]
    nb = s // Q_BLOCK
    blk = tuple(jnp.moveaxis(q.reshape((b, nb, Q_BLOCK) + q.shape[2:]), 1, 0) for q in qs)
    starts = jnp.arange(nb, dtype=jnp.int32) * Q_BLOCK
    out = lax.map(lambda a: fn(*a[0], a[1]), (blk, starts))
    return jnp.moveaxis(out, 0, 1).reshape((b, s) + out.shape[3:])


def dsa_attention(q, k, v, q_idx, k_idx, w_idx, topk):
    seq = k.shape[1]
    scale = HEAD_DIM ** -0.5

    def block(qb, qib, wib, start):
        adm = chunk_mask(start, seq)
        logits = jnp.einsum('bqhd,bsd->bqhs', qib, k_idx) * (IDX_DIM ** -0.5)
        score = jnp.einsum('bqh,bqhs->bqs', wib * (IDX_HEADS ** -0.5), jax.nn.relu(logits))
        score = jnp.where(adm[None], score.astype(jnp.float32), -jnp.inf)
        top_val, top_idx = lax.top_k(score, topk)
        valid = jnp.isfinite(top_val)
        k_sel = jax.vmap(lambda kb, ib: kb[ib])(k, top_idx)
        v_sel = jax.vmap(lambda vb, ib: vb[ib])(v, top_idx)
        att = jnp.einsum('bqhd,bqkhd->bhqk', qb, k_sel).astype(jnp.float32) * scale
        att = jnp.where(valid[:, None], att, -jnp.inf)
        p = jax.nn.softmax(att, axis=-1).astype(v.dtype)
        return jnp.einsum('bhqk,bqkhd->bqhd', p, v_sel)

    return sweep_query_blocks(block, q, q_idx, w_idx)


def mla_attention(q_nope, q_rope, k_nope, k_rope, v):
    seq = k_nope.shape[1]
    scale = (MLA_NOPE + MLA_ROPE) ** -0.5

    def block(qn, qr, start):
        adm = chunk_mask(start, seq)
        sc = (jnp.einsum('bqhd,bshd->bhqs', qn, k_nope)
              + jnp.einsum('bqhr,bsr->bhqs', qr, k_rope)).astype(jnp.float32) * scale
        sc = jnp.where(adm[None, None], sc, -jnp.inf)
        p = jax.nn.softmax(sc, axis=-1).astype(v.dtype)
        return jnp.einsum('bhqs,bshd->bqhd', p, v)

    return sweep_query_blocks(block, q_nope, q_rope)


def stick_breaking_attention(q, k, v):
    seq = k.shape[1]
    scale = HEAD_DIM ** -0.5
    k_pos = jnp.arange(seq)

    def block(qb, start):
        q_pos = start + jnp.arange(Q_BLOCK)
        before = k_pos[None, :] < q_pos[:, None]
        z = jnp.einsum('bqhd,bshd->bhqs', qb, k).astype(jnp.float32) * scale
        log_stay = jnp.where(before, jax.nn.log_sigmoid(-z), 0.0)
        later = lax.cumsum(log_stay, axis=log_stay.ndim - 1, reverse=True) - log_stay
        w = jnp.where(before, jnp.exp(jax.nn.log_sigmoid(z) + later), 0.0)
        return jnp.einsum('bhqs,bshd->bqhd', w.astype(v.dtype), v)

    return sweep_query_blocks(block, q)


def swiglu(h, w_gate, w_up, w_down):
    return (jax.nn.silu(h @ w_gate) * (h @ w_up)) @ w_down


def modulate(h, shift, scale):
    return h * (1.0 + scale[:, None, :]) + shift[:, None, :]


def setup_inputs(seed: int = 0) -> dict:
    key = jax.random.key(seed)
    ks = jax.random.split(key, 32)
    L, D = DEPTH, D_MODEL

    def dense(k, shape, fan_in, gain=1.0):
        return jax.random.normal(k, shape, jnp.float32) * (gain * fan_in ** -0.5)

    def gain(k, shape):
        return 1.0 + 0.05 * jax.random.normal(k, shape, jnp.float32)

    return {
        "x": jax.random.normal(ks[0], (BATCH, SEQ, D), jnp.float32),
        "c": jax.random.normal(ks[1], (BATCH, D), jnp.float32),
        "w_ada": dense(ks[2], (L, D, N_MOD * D), D, 0.1),
        "b_ada": 0.01 * jax.random.normal(ks[3], (L, N_MOD * D), jnp.float32),
        "g_ffn1": gain(ks[4], (L, D)),
        "w1_gate": dense(ks[5], (L, D, D_FF), D),
        "w1_up": dense(ks[6], (L, D, D_FF), D),
        "w1_down": dense(ks[7], (L, D_FF, D), D_FF),
        "g_mix": gain(ks[8], (L, D)),
        "w_in": dense(ks[9], (L, D, N_IN), D),
        "g_qa": gain(ks[10], (L, HEAD_DIM)),
        "g_ka": gain(ks[11], (L, HEAD_DIM)),
        "g_cq": gain(ks[12], (L, MLA_Q_RANK)),
        "g_ckv": gain(ks[13], (L, MLA_KV_RANK)),
        "w_uq": dense(ks[14], (L, MLA_Q_RANK, B_HEADS * (MLA_NOPE + MLA_ROPE)), MLA_Q_RANK),
        "w_ukv": dense(ks[15], (L, MLA_KV_RANK, B_HEADS * (MLA_NOPE + MLA_V)), MLA_KV_RANK),
        "g_q_nope": gain(ks[16], (L, MLA_NOPE)),
        "g_k_nope": gain(ks[17], (L, MLA_NOPE)),
        "g_q_rope": gain(ks[18], (L, MLA_ROPE)),
        "g_k_rope": gain(ks[19], (L, MLA_ROPE)),
        "w_out": dense(ks[20], (L, D_MIX, D), D_MIX),
        "g_ffn2": gain(ks[21], (L, D)),
        "w2_gate": dense(ks[22], (L, D, D_FF), D),
        "w2_up": dense(ks[23], (L, D, D_FF), D),
        "w2_down": dense(ks[24], (L, D_FF, D), D_FF),
    }


def reference(x, c, w_ada, b_ada, g_ffn1, w1_gate, w1_up, w1_down, g_mix, w_in,
              g_qa, g_ka, g_cq, g_ckv, w_uq, w_ukv, g_q_nope, g_k_nope, g_q_rope, g_k_rope,
              w_out, g_ffn2, w2_gate, w2_up, w2_down):
    b, s, _ = x.shape
    topk = min(TOPK_MAX, s // 4)
    cos_p, sin_p = rope_tables(s, PARTIAL_ROPE_DIM)
    cos_m, sin_m = rope_tables(s, MLA_ROPE)
    split_at = [int(v) for v in np.cumsum(SPLIT_SIZES)[:-1]]
    c_act = jax.nn.silu(c)

    for l in range(DEPTH):
        mod = c_act @ w_ada[l] + b_ada[l]
        (sh1, sc1, ga1, shm, scm, gam, sh2, sc2, ga2) = jnp.split(mod, N_MOD, axis=-1)

        h = modulate(rms_norm(x, g_ffn1[l]), sh1, sc1)
        x = x + 0.5 * (1.0 + ga1[:, None, :]) * swiglu(h, w1_gate[l], w1_up[l], w1_down[l])

        h = modulate(rms_norm(x, g_mix[l]), shm, scm)
        (qa, ka, va, qi, ki, wi, cq, ckv, kr, qc, kc, vc) = jnp.split(h @ w_in[l], split_at, axis=-1)

        qa = partial_rope(rms_norm(qa.reshape(b, s, A_HEADS, HEAD_DIM), g_qa[l]), cos_p, sin_p)
        ka = partial_rope(rms_norm(ka.reshape(b, s, A_HEADS, HEAD_DIM), g_ka[l]), cos_p, sin_p)
        va = va.reshape(b, s, A_HEADS, HEAD_DIM)
        out_a = dsa_attention(qa, ka, va, qi.reshape(b, s, IDX_HEADS, IDX_DIM), ki, wi, topk)

        qb = (rms_norm(cq, g_cq[l]) @ w_uq[l]).reshape(b, s, B_HEADS, MLA_NOPE + MLA_ROPE)
        kvb = (rms_norm(ckv, g_ckv[l]) @ w_ukv[l]).reshape(b, s, B_HEADS, MLA_NOPE + MLA_V)
        q_nope = rms_norm(qb[..., :MLA_NOPE], g_q_nope[l])
        q_rope = apply_rope(rms_norm(qb[..., MLA_NOPE:], g_q_rope[l]), cos_m, sin_m)
        k_nope = rms_norm(kvb[..., :MLA_NOPE], g_k_nope[l])
        vb = kvb[..., MLA_NOPE:]
        k_rope = apply_rope(rms_norm(kr, g_k_rope[l])[:, :, None, :], cos_m, sin_m)[:, :, 0]
        out_b = mla_attention(q_nope, q_rope, k_nope, k_rope, vb)

        out_c = stick_breaking_attention(qc.reshape(b, s, C_HEADS, HEAD_DIM),
                                         kc.reshape(b, s, C_HEADS, HEAD_DIM),
                                         vc.reshape(b, s, C_HEADS, HEAD_DIM))

        mixed = jnp.concatenate([out_a.reshape(b, s, -1), out_b.reshape(b, s, -1),
                                 out_c.reshape(b, s, -1)], axis=-1) @ w_out[l]
        x = x + (1.0 + gam[:, None, :]) * mixed

        h = modulate(rms_norm(x, g_ffn2[l]), sh2, sc2)
        x = x + 0.5 * (1.0 + ga2[:, None, :]) * swiglu(h, w2_gate[l], w2_up[l], w2_down[l])

    return x
```

```cpp
#include <hip/hip_runtime.h>
#include <cstdio>
#include <cstdint>

#ifndef MK_N_LAUNCHES
#define MK_N_LAUNCHES 1
#endif
#ifndef PH_STOP
#define PH_STOP 1000
#endif

#define GAS __attribute__((address_space(1)))
#define LAS __attribute__((address_space(3)))
typedef unsigned short bf16;
typedef unsigned v4u __attribute__((ext_vector_type(4)));
typedef unsigned v2u __attribute__((ext_vector_type(2)));
typedef float f32x4 __attribute__((ext_vector_type(4)));
typedef float f32x2 __attribute__((ext_vector_type(2)));
typedef float f32x16 __attribute__((ext_vector_type(16)));
typedef short bf16x8 __attribute__((ext_vector_type(8)));
typedef short s16x4 __attribute__((ext_vector_type(4)));
typedef GAS unsigned gu32;
#define RLX_AGENT __ATOMIC_RELAXED, __HIP_MEMORY_SCOPE_AGENT
#define LDS_WAIT() asm volatile("s_waitcnt lgkmcnt(0)" ::: "memory")
#define VM_WAIT() asm volatile("s_waitcnt vmcnt(0)" ::: "memory")
#define SBAR() __builtin_amdgcn_sched_barrier(0)
__device__ __forceinline__ unsigned cvt_pk_bf16(float lo, float hi) { unsigned r; asm volatile("v_cvt_pk_bf16_f32 %0, %1, %2" : "=v"(r) : "v"(lo), "v"(hi)); return r; }
__device__ __forceinline__ int lane_id_fresh() { int l; asm volatile("v_mbcnt_lo_u32_b32 %0, -1, 0\n\tv_mbcnt_hi_u32_b32 %0, -1, %0" : "=v"(l)); return l; }
__device__ __forceinline__ unsigned cvt_pk_bf16_nv(float lo, float hi) { unsigned r; asm("v_cvt_pk_bf16_f32 %0, %1, %2" : "=v"(r) : "v"(lo), "v"(hi)); return r; }
__device__ __forceinline__ float bf_lo(unsigned w) { return __uint_as_float(w << 16); }
__device__ __forceinline__ float bf_hi(unsigned w) { return __uint_as_float(w & 0xffff0000u); }

constexpr int NB = 8, SEQ = 4096, DM = 2048, M = NB * SEQ, FF = 5632, NLAYER = 2, NMOD = 9 * DM;
constexpr int NIN = 4816, NP = 5120;
constexpr int PC_QA = 0, PC_KA = 512, PC_VA = 1024, PC_QI = 1536, PC_KI = 2560, PC_WI = 2624, PC_CQ = 2688, PC_CKV = 3200, PC_KR = 3328, PC_QC = 3584, PC_KC = 4096, PC_VC = 4608;
constexpr int NQB = 1536, NKVB = 2048;
constexpr float NORM_EPS = 1e-6f;

namespace pg8 {
#define PG8_LAS __attribute__((address_space(3)))
typedef unsigned short bf16_t;
constexpr int BM = 256, BK = 64, HALF = 128, HTB = HALF * BK * 2  , STAGE_BYTES = 8 * HTB, NXCD = 8, WGM = 4;
__host__ __device__ __forceinline__ int lds_byte(int r, int c) { const int st = (r >> 4) * 2 + (c >> 5), rr = r & 15, cc = c & 31, ob = rr * 64 + cc * 2; return st * 1024 + (ob ^ (((ob >> 9) & 1) << 5)); }
__host__ __device__ __forceinline__ void stage_rc(int b, int& R, int& C) { const int st = b / 1024, sb = b % 1024, swz = sb ^ (((sb >> 9) & 1) << 5); R = (st >> 1) * 16 + swz / 64; C = (st & 1) * 32 + (swz % 64) / 2; }
__host__ __device__ __forceinline__ int perm32(int rho) { const int n = rho >> 4, i = rho & 15; return 8 * (i >> 2) + 4 * n + (i & 3); }
struct Unit { int pm, pn; };
struct Gemm { const bf16_t* A; const bf16_t* Bt; int M, N, K, lda, ldb; };
struct StaticOrder {
    int nM, nN, nwg, G, c, wgm, rev;
    __host__ __device__ void init(int M_, int N_, int G_, int c_, int wgm_ = WGM, int rev_ = 0) { nM = M_ / BM; nN = N_ / BM; nwg = nM * nN; G = G_; c = c_; wgm = wgm_; rev = rev_; }
    __host__ __device__ bool next(int i, Unit& u) const {
        const long L = (long)i * G + c; if (L >= nwg) return false;
        int wgid = (int)L; { const int q = nwg / NXCD, r = nwg % NXCD, xcd = wgid % NXCD, off = wgid / NXCD; wgid = (xcd < r ? xcd * (q + 1) : r * (q + 1) + (xcd - r) * q) + off; }
        const int nig = wgm * nN, gid = wgid / nig, fm = gid * wgm, gsz = (nM - fm) < wgm ? (nM - fm) : wgm;
        u.pm = fm + ((wgid % nig) % gsz); u.pn = (wgid % nig) / gsz; if (rev) u.pm = nM - 1 - u.pm; return true;
    }
};
struct EpiBf16 {
    static constexpr bool PERM = true;
    bf16_t* O; int ldc;
    __device__ __forceinline__ void operator()(const f32x4 (&acc)[2][2][4][2], const Unit& u, int wr, int wc, int fr, int fq) const {
        const int row0 = u.pm * BM + wr * 64 + fr, col0 = u.pn * BM + wc * 32 + 8 * fq;
#pragma unroll
        for (int ai = 0; ai < 2; ++ai)
#pragma unroll
            for (int m = 0; m < 4; ++m) { bf16_t* rowp = O + (size_t)(row0 + ai * HALF + m * 16) * ldc + col0;
#pragma unroll
                for (int bj = 0; bj < 2; ++bj) { const f32x4 v0 = acc[ai][bj][m][0], v1 = acc[ai][bj][m][1];
                    v4u w; w.x = cvt_pk_bf16(v0[0], v0[1]); w.y = cvt_pk_bf16(v0[2], v0[3]); w.z = cvt_pk_bf16(v1[0], v1[1]); w.w = cvt_pk_bf16(v1[2], v1[3]);
                    *(v4u*)(rowp + bj * HALF) = w; } }
    }
};
struct EpiKV {
    static constexpr bool PERM = true;
    bf16_t* O; const float* gk; PG8_LAS float* part; int ldc;
    __device__ __forceinline__ void operator()(const f32x4 (&acc)[2][2][4][2], const Unit& u, int wr, int wc, int fr, int fq) const {
        const int row0 = u.pm * BM + wr * 64 + fr, col0 = u.pn * BM + wc * 32 + 8 * fq;
#pragma unroll
        for (int ai = 0; ai < 2; ++ai)
#pragma unroll
            for (int m = 0; m < 4; ++m) { const f32x4 v0 = acc[ai][0][m][0], v1 = acc[ai][0][m][1];
                float s = ((v0[0] * v0[0] + v0[1] * v0[1]) + (v0[2] * v0[2] + v0[3] * v0[3])) + ((v1[0] * v1[0] + v1[1] * v1[1]) + (v1[2] * v1[2] + v1[3] * v1[3]));
                { auto r = __builtin_amdgcn_permlane16_swap(__float_as_uint(s), __float_as_uint(s), false, false); s = __uint_as_float(r[0]) + __uint_as_float(r[1]); }
                { auto r = __builtin_amdgcn_permlane32_swap(__float_as_uint(s), __float_as_uint(s), false, false); s = __uint_as_float(r[0]) + __uint_as_float(r[1]); }
                if (fq == 0) part[(wr * 128 + ai * 64 + m * 16 + fr) * 4 + wc] = s; }
        asm volatile("s_waitcnt lgkmcnt(0)" ::: "memory"); __builtin_amdgcn_s_barrier(); asm volatile("" ::: "memory");
        const f32x4 g0 = *(const f32x4*)(gk + wc * 32 + 8 * fq), g1 = *(const f32x4*)(gk + wc * 32 + 8 * fq + 4);
#pragma unroll
        for (int ai = 0; ai < 2; ++ai)
#pragma unroll
            for (int m = 0; m < 4; ++m) { bf16_t* rowp = O + (size_t)(row0 + ai * HALF + m * 16) * ldc + col0;
                const f32x4 q = *(const PG8_LAS f32x4*)(part + (wr * 128 + ai * 64 + m * 16 + fr) * 4);
                const float rstd = rsqrtf(((q[0] + q[1]) + (q[2] + q[3])) * (1.0f / 128) + NORM_EPS);
                const f32x4 v0 = acc[ai][0][m][0], v1 = acc[ai][0][m][1];
                v4u w; w.x = cvt_pk_bf16(v0[0] * rstd * g0[0], v0[1] * rstd * g0[1]); w.y = cvt_pk_bf16(v0[2] * rstd * g0[2], v0[3] * rstd * g0[3]);
                w.z = cvt_pk_bf16(v1[0] * rstd * g1[0], v1[1] * rstd * g1[1]); w.w = cvt_pk_bf16(v1[2] * rstd * g1[2], v1[3] * rstd * g1[3]);
                *(v4u*)rowp = w;
                const f32x4 x0 = acc[ai][1][m][0], x1 = acc[ai][1][m][1];
                v4u z; z.x = cvt_pk_bf16(x0[0], x0[1]); z.y = cvt_pk_bf16(x0[2], x0[3]); z.z = cvt_pk_bf16(x1[0], x1[1]); z.w = cvt_pk_bf16(x1[2], x1[3]);
                *(v4u*)(rowp + HALF) = z; }
    }
};
__device__ __forceinline__ void silu_mul4(const f32x4 g, const f32x4 u, unsigned& o0, unsigned& o1) {
    float t0, t1, t2, t3;
    asm volatile(
        "v_exp_f32_e32 %0, %4\n\tv_exp_f32_e32 %1, %5\n\tv_exp_f32_e32 %2, %6\n\tv_exp_f32_e32 %3, %7\n\t"
        "v_add_f32_e32 %0, 1.0, %0\n\tv_add_f32_e32 %1, 1.0, %1\n\tv_add_f32_e32 %2, 1.0, %2\n\tv_add_f32_e32 %3, 1.0, %3\n\t"
        "v_rcp_f32_e32 %0, %0\n\tv_rcp_f32_e32 %1, %1\n\tv_rcp_f32_e32 %2, %2\n\tv_rcp_f32_e32 %3, %3\n\t"
        "v_mul_f32_e32 %0, %4, %0\n\tv_mul_f32_e32 %1, %5, %1\n\tv_mul_f32_e32 %2, %6, %2\n\tv_mul_f32_e32 %3, %7, %3\n\t"
        "v_mul_f32_e32 %0, %8, %0\n\tv_mul_f32_e32 %1, %9, %1\n\tv_mul_f32_e32 %2, %10, %2\n\tv_mul_f32_e32 %3, %11, %3\n\t"
        "v_cvt_pk_bf16_f32 %0, %0, %1\n\tv_cvt_pk_bf16_f32 %2, %2, %3"
        : "=&v"(t0), "=&v"(t1), "=&v"(t2), "=&v"(t3)
        : "v"(g[0]), "v"(g[1]), "v"(g[2]), "v"(g[3]), "v"(u[0]), "v"(u[1]), "v"(u[2]), "v"(u[3]));
    o0 = __float_as_uint(t0); o1 = __float_as_uint(t2);
}
struct EpiSwiGLU {
    static constexpr bool PERM = true;
    bf16_t* O; int ldc;
    __device__ __forceinline__ void operator()(const f32x4 (&acc)[2][2][4][2], const Unit& u, int wr, int wc, int fr, int fq) const {
        const int row0 = u.pm * BM + wr * 64 + fr, col0 = u.pn * HALF + wc * 32 + 8 * fq;
#pragma unroll
        for (int ai = 0; ai < 2; ++ai)
#pragma unroll
            for (int m = 0; m < 4; ++m) { bf16_t* rowp = O + (size_t)(row0 + ai * HALF + m * 16) * ldc + col0;
                unsigned w0, w1, w2, w3; silu_mul4(acc[ai][0][m][0], acc[ai][1][m][0], w0, w1); silu_mul4(acc[ai][0][m][1], acc[ai][1][m][1], w2, w3);
                v4u w; w.x = w0; w.y = w1; w.z = w2; w.w = w3;
                *(v4u*)rowp = w; }
    }
};
struct EpiResid {
    static constexpr bool PERM = false;
    const float* base; float* out; const float* gate; float s;
    __device__ __forceinline__ void operator()(const f32x4 (&acc)[2][2][4][2], const Unit& u, int wr, int wc, int fr, int fq) const {
        const int row0 = u.pm * BM + wr * 64 + fr, col0 = u.pn * BM + wc * 32 + 4 * fq;
        const float* gp = gate + (size_t)((u.pm * BM) / SEQ) * NMOD + col0;
        f32x4 gv[2][2];
#pragma unroll
        for (int bj = 0; bj < 2; ++bj)
#pragma unroll
            for (int n = 0; n < 2; ++n) { const f32x4 g = *(const f32x4*)(gp + bj * HALF + n * 16); gv[bj][n] = (g + 1.0f) * s; }
#define ER_OFF(e) ((size_t)(row0 + ((e) >> 4) * HALF + (((e) >> 2) & 3) * 16) * DM + col0 + (((e) >> 1) & 1) * HALF + ((e) & 1) * 16)
        f32x4 bs[16];
#pragma unroll
        for (int e = 0; e < 16; ++e) bs[e] = *(const f32x4*)(base + ER_OFF(e));
#pragma unroll
        for (int e = 0; e < 32; ++e) {
            const f32x4 v = bs[e & 15] + gv[(e >> 1) & 1][e & 1] * acc[e >> 4][(e >> 1) & 1][(e >> 2) & 3][e & 1];
            *(f32x4*)(out + ER_OFF(e)) = v;
            if (e + 16 < 32) bs[e & 15] = *(const f32x4*)(base + ER_OFF(e + 16));
        }
#undef ER_OFF
    }
};
template <class Epi, class Sched, bool ALIGN_EPI = false, bool SP2 = false>
__device__ __forceinline__ void gemm_phase(PG8_LAS unsigned char* lds, const Gemm g, const Sched& S, const Epi& E, int wv) {
    int wid_ = wv; asm volatile("" : "+s"(wid_));
    const int wid = wid_, lane = lane_id_fresh(), tid = (wid << 6) | lane, wr = wid >> 2, wc = wid & 3, fr = lane & 15, fq = lane >> 4;
    int K = g.K; asm volatile("" : "+s"(K)); const int nt = K / BK;
    unsigned voffA[2], voffB[2];
#pragma unroll
    for (int i = 0; i < 2; ++i) { int R, C; stage_rc(tid * 16 + i * 8192, R, C); const int Rb = Epi::PERM ? ((R & ~31) + perm32(R & 31)) : R;
        voffA[i] = (unsigned)(R * g.lda + C) * 2u; voffB[i] = (unsigned)(Rb * g.ldb + C) * 2u; }
    const size_t kstep = (size_t)(BK * 2);
    const size_t hstepA = (size_t)HALF * g.lda * 2, hstepB = (size_t)HALF * g.ldb * 2;
    const size_t tstepA = 2 * hstepA, tstepB = 2 * hstepB;
    const unsigned ldsw = (unsigned)wid * 1024u;
    const int aoff = lds_byte(wr * 64 + fr, fq * 8), boff = lds_byte(wc * 32 + fr, fq * 8);
#define PG8_SA(b, h) (((b) * 2 + (h)) * HTB)
#define PG8_SB(b, h) ((4 + (b) * 2 + (h)) * HTB)
#define PG8_STAGE(bufoff, gbase, voff) do { const char* _gb = (const char*)(gbase); asm volatile("" : "+s"(_gb));   \
        _Pragma("unroll") for (int _i = 0; _i < 2; ++_i) __builtin_amdgcn_global_load_lds((const unsigned*)(_gb + (voff)[_i]), (PG8_LAS unsigned*)(lds + (bufoff) + ldsw + _i * 8192), 16, 0, 0); } while (0)
#define PG8_VOFF_FRESH asm volatile("" : "+v"(voffA[0]), "+v"(voffA[1]), "+v"(voffB[0]), "+v"(voffB[1]))
#define PG8_LDA(dst, b, h) do { _Pragma("unroll") for (int m = 0; m < 4; ++m) _Pragma("unroll") for (int k = 0; k < 2; ++k) dst[m][k] = *(const PG8_LAS bf16x8*)(lds + PG8_SA(b, h) + aoff + m * 2048 + k * 1024); } while (0)
#define PG8_LDB(dst, b, h) do { _Pragma("unroll") for (int n = 0; n < 2; ++n) _Pragma("unroll") for (int k = 0; k < 2; ++k) dst[n][k] = *(const PG8_LAS bf16x8*)(lds + PG8_SB(b, h) + boff + n * 2048 + k * 1024); } while (0)
#define PG8_MFMA(m, n, k, C) __builtin_amdgcn_mfma_f32_16x16x32_bf16(Bt_[n][k], At_[m][k], C, 0, 0, 0)
#define PG8_MMA(ai, bj, At, Bt, FIRST) do { auto& At_ = At; auto& Bt_ = Bt; __builtin_amdgcn_s_setprio(1); \
        if (FIRST) { _Pragma("unroll") for (int m = 0; m < 4; ++m) _Pragma("unroll") for (int n = 0; n < 2; ++n) acc[ai][bj][m][n] = PG8_MFMA(m, n, 0, ((f32x4){0.f, 0.f, 0.f, 0.f})); } \
        else       { _Pragma("unroll") for (int m = 0; m < 4; ++m) _Pragma("unroll") for (int n = 0; n < 2; ++n) acc[ai][bj][m][n] = PG8_MFMA(m, n, 0, acc[ai][bj][m][n]); } \
        _Pragma("unroll") for (int m = 0; m < 4; ++m) _Pragma("unroll") for (int n = 0; n < 2; ++n) acc[ai][bj][m][n] = PG8_MFMA(m, n, 1, acc[ai][bj][m][n]); \
        __builtin_amdgcn_s_setprio(0); } while (0)
#define PG8_WAIT_V(n) asm volatile("s_waitcnt vmcnt(" #n ")" ::: "memory")
#define PG8_WAIT_L(n) asm volatile("s_waitcnt lgkmcnt(" #n ")" ::: "memory")
#define PG8_BAR __builtin_amdgcn_s_barrier()
#define PG8_SCHED __builtin_amdgcn_sched_barrier(0)
    Unit cur, nxt; int ui = 0;
    if (!S.next(0, cur)) return;
    static_assert(SP2, "only the two-super-phase K-loop is kept");
    f32x4 acc[2][2][4][2];
    bf16x8 At[4][2], B0[2][2], B1[2][2];
    const char* cA = (const char*)g.A + (size_t)cur.pm * tstepA; const char* cB = (const char*)g.Bt + (size_t)cur.pn * tstepB;
    PG8_VOFF_FRESH;
    if constexpr (SP2) {
        PG8_STAGE(PG8_SB(0, 0), cB, voffB); PG8_STAGE(PG8_SB(0, 1), cB + hstepB, voffB); PG8_STAGE(PG8_SA(0, 0), cA, voffA); PG8_STAGE(PG8_SA(0, 1), cA + hstepA, voffA);
        if (wr == 1) PG8_BAR;
        PG8_WAIT_V(2); PG8_BAR;
        PG8_STAGE(PG8_SB(1, 0), cB + kstep, voffB); PG8_STAGE(PG8_SA(1, 0), cA + kstep, voffA); PG8_STAGE(PG8_SB(1, 1), cB + hstepB + kstep, voffB);
        PG8_WAIT_V(6); PG8_BAR;
    } else {
        PG8_STAGE(PG8_SB(0, 0), cB, voffB); PG8_STAGE(PG8_SA(0, 0), cA, voffA); PG8_STAGE(PG8_SB(0, 1), cB + hstepB, voffB); PG8_STAGE(PG8_SA(0, 1), cA + hstepA, voffA);
        if (wr == 1) PG8_BAR;
        PG8_WAIT_V(4); PG8_BAR;
        PG8_STAGE(PG8_SB(1, 0), cB + kstep, voffB); PG8_STAGE(PG8_SA(1, 0), cA + kstep, voffA); PG8_STAGE(PG8_SB(1, 1), cB + hstepB + kstep, voffB);
        PG8_WAIT_V(6); PG8_BAR;
    }
    for (;;) {
        const bool has_next = S.next(ui + 1, nxt);
        const char* nA = has_next ? (const char*)g.A + (size_t)nxt.pm * tstepA : cA; const char* nB = has_next ? (const char*)g.Bt + (size_t)nxt.pn * tstepB : cB;
#define PG8_KT2(t, FIRST) do { \
            const bool last = ((t) == nt - 2); \
            const char* a1 = cA + (size_t)((t) + 1) * kstep; \
            const char* a2 = last ? nA : cA + (size_t)((t) + 2) * kstep; const char* b2 = last ? nB : cB + (size_t)((t) + 2) * kstep; \
            const char* a3 = a2 + kstep; const char* b3 = b2 + kstep; PG8_VOFF_FRESH; \
            PG8_LDB(B0, 0, 0); PG8_LDB(B1, 0, 1); PG8_SCHED; PG8_LDA(At, 0, 0); PG8_STAGE(PG8_SA(1, 1), a1 + hstepA, voffA); \
            PG8_WAIT_V(8); PG8_WAIT_L(0); PG8_BAR; PG8_MMA(0, 0, At, B0, FIRST); PG8_MMA(0, 1, At, B1, FIRST); PG8_BAR; PG8_SCHED; \
            PG8_LDA(At, 0, 1); PG8_STAGE(PG8_SB(0, 0), b2, voffB); PG8_STAGE(PG8_SB(0, 1), b2 + hstepB, voffB); PG8_STAGE(PG8_SA(0, 0), a2, voffA); \
            PG8_WAIT_V(8); PG8_WAIT_L(0); PG8_BAR; PG8_MMA(1, 0, At, B0, FIRST); PG8_MMA(1, 1, At, B1, FIRST); PG8_BAR; PG8_SCHED; \
            PG8_LDB(B0, 1, 0); PG8_LDB(B1, 1, 1); PG8_SCHED; PG8_LDA(At, 1, 0); PG8_STAGE(PG8_SA(0, 1), a2 + hstepA, voffA); \
            PG8_WAIT_V(8); PG8_WAIT_L(0); PG8_BAR; PG8_MMA(0, 0, At, B0, false); PG8_MMA(0, 1, At, B1, false); PG8_BAR; PG8_SCHED; \
            PG8_LDA(At, 1, 1); PG8_STAGE(PG8_SB(1, 0), b3, voffB); PG8_STAGE(PG8_SB(1, 1), b3 + hstepB, voffB); PG8_STAGE(PG8_SA(1, 0), a3, voffA); \
            PG8_WAIT_V(8); PG8_WAIT_L(0); PG8_BAR; PG8_MMA(1, 0, At, B0, false); PG8_MMA(1, 1, At, B1, false); PG8_BAR; PG8_SCHED; \
        } while (0)
        for (int t = 0; t < nt; t += 2) { const bool first = (t == 0); PG8_KT2(t, first); }
#undef PG8_KT2
        if constexpr (ALIGN_EPI) { if (wr == 0) PG8_BAR; }
        { const int le = lane_id_fresh(); E(acc, cur, wr, wc, le & 15, le >> 4); }
        if (!has_next) break;
        cur = nxt; cA = nA; cB = nB; ++ui;
        if constexpr (ALIGN_EPI) { if (wr == 1) PG8_BAR; }
    }
    PG8_WAIT_V(0);
    if constexpr (!ALIGN_EPI) { if (wr == 0) PG8_BAR; }
    PG8_BAR;
#undef PG8_SA
#undef PG8_SB
#undef PG8_STAGE
#undef PG8_VOFF_FRESH
#undef PG8_LDA
#undef PG8_LDB
#undef PG8_MMA
#undef PG8_WAIT_V
#undef PG8_WAIT_L
#undef PG8_BAR
#undef PG8_SCHED
}
}

constexpr size_t MiB = 1u << 20;
constexpr size_t WS_CTL = 0, CTL_ZERO_BYTES = 1 * MiB;
constexpr size_t WS_MOD = 1 * MiB;
constexpr size_t WS_TAB = 3 * MiB;
constexpr size_t WS_W = 5 * MiB;
constexpr size_t W_GU = (size_t)2 * FF * DM * 2, W_DN = (size_t)DM * FF * 2, W_IN = (size_t)NP * DM * 2, W_UQ = (size_t)NQB * 512 * 2, W_UKV = (size_t)NKVB * 128 * 2, W_OUT = (size_t)DM * DM * 2;
constexpr size_t LW_GU1 = 0, LW_DN1 = LW_GU1 + W_GU, LW_GU2 = LW_DN1 + W_DN, LW_DN2 = LW_GU2 + W_GU, LW_IN = LW_DN2 + W_DN, LW_UQ = LW_IN + W_IN, LW_UKV = LW_UQ + W_UQ, LW_OUT = LW_UKV + W_UKV, LW_BYTES = LW_OUT + W_OUT;
constexpr size_t WS_H = WS_W + NLAYER * LW_BYTES;
constexpr size_t WS_SCR = WS_H + (size_t)M * DM * 2;
constexpr size_t WS_HID = WS_SCR;
constexpr size_t WS_P = WS_SCR, WS_QB = WS_P + (size_t)M * NP * 2, WS_KVB = WS_QB + (size_t)M * NQB * 2, WS_MASK = WS_KVB + (size_t)M * NKVB * 2, WS_KI = WS_MASK + (size_t)M * 128 * 4, WS_MIXEND = WS_KI + (size_t)M * 64 * 2;
constexpr size_t WS_END = (WS_MIXEND > WS_HID + (size_t)M * FF * 2) ? WS_MIXEND : WS_HID + (size_t)M * FF * 2;
static_assert(LW_BYTES % 256 == 0 && WS_H % 256 == 0 && WS_SCR % 256 == 0, "alignment");
constexpr int CW_BAR = 4096;
constexpr int CW_QUEUE = 16384;

constexpr int RING_BYTES = 131072;
constexpr int LDSCTL_OFF = RING_BYTES, MISC_OFF = LDSCTL_OFF + 320;
constexpr int LDS_BYTES = 147456;
constexpr int NWAVES = 8;

#define XB_TMO      128
#define XB_XCNT(j)  (256  + 64 * (j))
#define XB_XSUB(j)  (1280 + 64 * (j))
#define XB_XGEN(j)  (2304 + 64 * (j))
#define XB_TOP      3328
#define XB_TOPGEN   3392
#define XCD_BAR_WORDS 3456
#define XB_SPIN_CAP (1u << 18)

__device__ __forceinline__ unsigned xb_ld(unsigned* p)              { return __hip_atomic_load(p, __ATOMIC_RELAXED, __HIP_MEMORY_SCOPE_AGENT); }
__device__ __forceinline__ unsigned xb_add(unsigned* p, unsigned v) { return __hip_atomic_fetch_add(p, v, __ATOMIC_RELAXED, __HIP_MEMORY_SCOPE_AGENT); }
__device__ __forceinline__ unsigned xb_xcc_id() { return (unsigned)__builtin_amdgcn_s_getreg((3 << 11) | 20) & 0xFu; }
#define XB_SPIN(cond, bar) do { unsigned _sp = 0; while (cond) { __builtin_amdgcn_s_sleep(1); \
    if ((++_sp & 255u) == 0u) { if (xb_ld(&(bar)[XB_TMO])) break; if (_sp > XB_SPIN_CAP) { atomicAdd(&(bar)[XB_TMO], 1u); break; } } } } while (0)

struct XcdBarrier {
    unsigned* bar; unsigned x;
    volatile LAS unsigned* st;
};

__device__ __forceinline__ XcdBarrier xcd_barrier_post(unsigned* bar, volatile LAS unsigned* st) {
    XcdBarrier b; b.bar = bar; b.x = xb_xcc_id(); b.st = st;
    if (threadIdx.x == 0) (void)xb_add(&bar[XB_XCNT(b.x)], 1u);
    return b;
}
__device__ __forceinline__ void xcd_barrier_complete(unsigned* bar, unsigned x, unsigned& nloc, unsigned& nx) {
    const unsigned G = gridDim.x * gridDim.y * gridDim.z;
    unsigned sum, cnt, mine, sp = 0u;
    for (;;) {
        sum = 0u; cnt = 0u; mine = 0u;
#pragma unroll
        for (unsigned j = 0; j < 16; ++j) { const unsigned c = xb_ld(&bar[XB_XCNT(j)]); sum += c; cnt += (c > 0u) ? 1u : 0u; mine = (j == x) ? c : mine; }
        if (sum == G) break;
        __builtin_amdgcn_s_sleep(1);
        if ((++sp & 255u) == 0u) { if (xb_ld(&bar[XB_TMO])) break; if (sp > XB_SPIN_CAP) { atomicAdd(&bar[XB_TMO], 1u); break; } }
    }
    nloc = mine > 0u ? mine : 1u; nx = cnt > 0u ? cnt : 1u;
}

__device__ __forceinline__ void xcd_barrier(const XcdBarrier& b, const bool t0) {
    asm volatile("s_waitcnt vmcnt(0)" ::: "memory");
    __syncthreads();
    if (t0) {
        unsigned* bar = b.bar;
        __builtin_amdgcn_s_waitcnt(0);
        unsigned nloc = b.st[0], nx = b.st[1];
        if (nloc == 0u) { xcd_barrier_complete(bar, b.x, nloc, nx); b.st[0] = nloc; b.st[1] = nx; }
        const unsigned old = xb_add(&bar[XB_XSUB(b.x)], 1u);
        const unsigned gen = old / nloc;
        if (old + 1u == (gen + 1u) * nloc) {
            __builtin_amdgcn_fence(__ATOMIC_RELEASE, "agent");
            asm volatile("s_waitcnt vmcnt(0)" ::: "memory");
            const unsigned og = xb_add(&bar[XB_TOP], 1u);
            const unsigned tg = og / nx;
            if (og + 1u == (tg + 1u) * nx) xb_add(&bar[XB_TOPGEN], 1u);
            else XB_SPIN(xb_ld(&bar[XB_TOPGEN]) == tg, bar);
            __builtin_amdgcn_fence(__ATOMIC_ACQUIRE, "agent");
            xb_add(&bar[XB_XGEN(b.x)], 1u);
            asm volatile("s_waitcnt vmcnt(0)" ::: "memory");
        } else {
            XB_SPIN(xb_ld(&bar[XB_XGEN(b.x)]) == gen, bar);
            __builtin_amdgcn_fence(__ATOMIC_ACQUIRE, "agent");
            asm volatile("s_waitcnt vmcnt(0)" ::: "memory");
        }
    }
    __syncthreads();
}

struct Params { const float* in[25]; float* out; unsigned char* ws; int ph_lo, ph_hi; };
typedef const __attribute__((address_space(4))) Params* KParams;
enum { I_X = 0, I_C, I_WADA, I_BADA, I_GFFN1, I_W1G, I_W1U, I_W1D, I_GMIX, I_WIN, I_GQA, I_GKA, I_GCQ, I_GCKV, I_WUQ, I_WUKV, I_GQN, I_GKN, I_GQR, I_GKR, I_WOUT, I_GFFN2, I_W2G, I_W2U, I_W2D };
struct Frame {
    LAS unsigned char* lds; volatile LAS unsigned* MISC; gu32* ctl;
    int tid, lane, wave, vcu, G, wave0;
};
__device__ __forceinline__ void relaunder(Frame& F) { int w = F.wave0; asm volatile("" : "+s"(w)); const int l = lane_id_fresh(); F.wave = w; F.lane = l; F.tid = (w << 6) | l; }
#define XS_DPP(x, ctrl) __builtin_amdgcn_update_dpp(0, (x), (ctrl), 0xF, 0xF, true)
template <int W> __device__ __forceinline__ float xsum(float v) {
    if constexpr (W > 1) v += __int_as_float(XS_DPP(__float_as_int(v), 0xB1));
    if constexpr (W > 2) v += __int_as_float(XS_DPP(__float_as_int(v), 0x4E));
    if constexpr (W > 4) v += __int_as_float(XS_DPP(__float_as_int(v), 0x141));
    if constexpr (W > 8) v += __int_as_float(XS_DPP(__float_as_int(v), 0x140));
    if constexpr (W > 16) { auto r = __builtin_amdgcn_permlane16_swap(__float_as_uint(v), __float_as_uint(v), false, false); v = __uint_as_float(r[0]) + __uint_as_float(r[1]); }
    if constexpr (W > 32) { auto r = __builtin_amdgcn_permlane32_swap(__float_as_uint(v), __float_as_uint(v), false, false); v = __uint_as_float(r[0]) + __uint_as_float(r[1]); }
    return v;
}
template <int W> __device__ __forceinline__ int xsum_i(int v) {
    if constexpr (W > 1) v += XS_DPP(v, 0xB1);
    if constexpr (W > 2) v += XS_DPP(v, 0x4E);
    if constexpr (W > 4) v += XS_DPP(v, 0x141);
    if constexpr (W > 8) v += XS_DPP(v, 0x140);
    if constexpr (W > 16) { auto r = __builtin_amdgcn_permlane16_swap((unsigned)v, (unsigned)v, false, false); v = (int)(r[0] + r[1]); }
    if constexpr (W > 32) { auto r = __builtin_amdgcn_permlane32_swap((unsigned)v, (unsigned)v, false, false); v = (int)(r[0] + r[1]); }
    return v;
}
template <int W> __device__ __forceinline__ unsigned xmax_u(unsigned v) {
    if constexpr (W > 1) v = max(v, (unsigned)XS_DPP((int)v, 0xB1));
    if constexpr (W > 2) v = max(v, (unsigned)XS_DPP((int)v, 0x4E));
    if constexpr (W > 4) v = max(v, (unsigned)XS_DPP((int)v, 0x141));
    if constexpr (W > 8) v = max(v, (unsigned)XS_DPP((int)v, 0x140));
    if constexpr (W > 16) { auto r = __builtin_amdgcn_permlane16_swap(v, v, false, false); v = max(r[0], r[1]); }
    if constexpr (W > 32) { auto r = __builtin_amdgcn_permlane32_swap(v, v, false, false); v = max(r[0], r[1]); }
    return v;
}
template <int W> __device__ __forceinline__ unsigned xmin_u(unsigned v) { return ~xmax_u<W>(~v); }
__device__ __forceinline__ float wave_sum(float v) { return xsum<64>(v); }
__device__ __forceinline__ int q_next(Frame& F, int q) {
    __syncthreads();
    if (F.tid == 0) F.MISC[0] = __hip_atomic_fetch_add(F.ctl + CW_QUEUE + 64 * q, 1u, RLX_AGENT);
    __syncthreads();
    return (int)F.MISC[0];
}

struct XD { const float* src; bf16* dst; int ldsrc, lddst, width; float wsc; };
__device__ __forceinline__ void xpose_load(const XD& d, int lane, float (&v)[32]) {
    const int c = lane & 31, h = lane >> 5, cc = min(c, max(d.width - 1, 0));
    const unsigned lo = (unsigned)(h * d.ldsrc + cc) * 4u;
#pragma unroll
    for (int i = 0; i < 32; ++i) { const char* rb = (const char*)d.src + (size_t)(2 * i) * d.ldsrc * 4; v[i] = *(const float*)(rb + lo); }
}
__device__ __forceinline__ void xpose_emit(const XD& d, int lane, const float (&v)[32], LAS float* scr) {
    const int c = lane & 31, h = lane >> 5; const bool ok = c < d.width;
#pragma unroll
    for (int i = 0; i < 32; ++i) scr[(2 * i + h) * 33 + c] = ok ? v[i] * d.wsc : 0.f;
    LDS_WAIT(); asm volatile("" ::: "memory");
    const int c8 = lane & 7;
#pragma unroll
    for (int j = 0; j < 4; ++j) { const int n = (lane >> 3) + 8 * j; const LAS float* s = scr + (8 * c8) * 33 + n;
        v4u o; o.x = cvt_pk_bf16_nv(s[0 * 33], s[1 * 33]); o.y = cvt_pk_bf16_nv(s[2 * 33], s[3 * 33]); o.z = cvt_pk_bf16_nv(s[4 * 33], s[5 * 33]); o.w = cvt_pk_bf16_nv(s[6 * 33], s[7 * 33]);
        if (n < d.width) *(v4u*)(d.dst + (size_t)n * d.lddst + 8 * c8) = o; }
    LDS_WAIT(); asm volatile("" ::: "memory");
}
constexpr int XB_FF = 5632, XB_WIN = 32 * 151, XB_UQ = 7 * 48, XB_UKV = 2 * 64, XB_OUT = 32 * 64;
constexpr int XB_LAYER = 6 * XB_FF + XB_WIN + XB_UQ + XB_UKV + XB_OUT, XB_TOTAL = NLAYER * XB_LAYER;
constexpr int XPW = 2, XCHUNKS = (XB_TOTAL + 8 * XPW - 1) / (8 * XPW);
constexpr int ADA_ITEMS = NLAYER * 72, P0_ITEMS = ADA_ITEMS + XCHUNKS;
#define XD_SET(W_, ldsrc_, k0_, csrc_, width_, WT_, lddst_, drow_) do { d.src = (W_) + (size_t)(k0_) * (ldsrc_) + (csrc_); d.ldsrc = (ldsrc_); d.width = (width_); d.dst = (WT_) + (size_t)(drow_) * (lddst_) + (k0_); d.lddst = (lddst_); } while (0)
__device__ __forceinline__ XD xpose_desc(KParams p, int blk) {
    XD d; d.src = p->in[I_WOUT]; d.dst = (bf16*)(p->ws + WS_W); d.ldsrc = 0; d.lddst = 0; d.width = 0; d.wsc = 1.0f;
    if (blk >= XB_TOTAL) return d;
    const int l = blk / XB_LAYER; int r = blk % XB_LAYER;
    unsigned char* wl = p->ws + WS_W + (size_t)l * LW_BYTES;
    if (r < 6 * XB_FF) {
        const int j = r / XB_FF, b = r % XB_FF, f2 = j / 3, jj = j % 3;
        if (jj < 2) { const int kb = b / 176, nb = b % 176, n = 32 * nb;
            const float* W = p->in[(f2 ? I_W2G : I_W1G) + jj] + (size_t)l * DM * FF;
            XD_SET(W, FF, 64 * kb, n, 32, (bf16*)(wl + (f2 ? LW_GU2 : LW_GU1)), DM, (n >> 7) * 256 + (n & 127) + 128 * jj); d.wsc = jj == 0 ? -1.4426950408889634f : -0.6931471805599453f;
        } else { const int kb = b / 64, nb = b % 64;
            const float* W = p->in[f2 ? I_W2D : I_W1D] + (size_t)l * FF * DM;
            XD_SET(W, DM, 64 * kb, 32 * nb, 32, (bf16*)(wl + (f2 ? LW_DN2 : LW_DN1)), FF, 32 * nb); }
        return d; }
    r -= 6 * XB_FF;
    if (r < XB_WIN) { const int kb = r / 151, nb = r % 151;
        int s0, d0, w = 32, nb0;
        if (nb < 16) { s0 = 0; d0 = PC_QA; nb0 = 0; } else if (nb < 32) { s0 = 512; d0 = PC_KA; nb0 = 16; } else if (nb < 48) { s0 = 1024; d0 = PC_VA; nb0 = 32; }
        else if (nb < 80) { s0 = 1536; d0 = PC_QI; nb0 = 48; } else if (nb < 82) { s0 = 2560; d0 = PC_KI; nb0 = 80; } else if (nb < 83) { s0 = 2624; d0 = PC_WI; nb0 = 82; w = 16; }
        else if (nb < 97) { s0 = 2640; d0 = PC_CQ; nb0 = 83; } else if (nb < 101) { s0 = 3088; d0 = PC_CKV; nb0 = 97; } else if (nb < 103) { s0 = 3216; d0 = PC_KR; nb0 = 101; }
        else if (nb < 119) { s0 = 3280; d0 = PC_QC; nb0 = 103; } else if (nb < 135) { s0 = 3792; d0 = PC_KC; nb0 = 119; } else { s0 = 4304; d0 = PC_VC; nb0 = 135; }
        const int o = 32 * (nb - nb0);
        XD_SET(p->in[I_WIN] + (size_t)l * DM * NIN, NIN, 64 * kb, s0 + o, w, (bf16*)(wl + LW_IN), DM, d0 + o); return d; }
    r -= XB_WIN;
    if (r < XB_UQ) { const int kb = r / 48, nb = r % 48; XD_SET(p->in[I_WUQ] + (size_t)l * 448 * NQB, NQB, 64 * kb, 32 * nb, 32, (bf16*)(wl + LW_UQ), 512, 32 * nb); return d; }
    r -= XB_UQ;
    if (r < XB_UKV) { const int kb = r / 64, nb = r % 64; XD_SET(p->in[I_WUKV] + (size_t)l * 128 * NKVB, NKVB, 64 * kb, 32 * nb, 32, (bf16*)(wl + LW_UKV), 128, 32 * nb); return d; }
    r -= XB_UKV;
    { const int kb = r / 64, nb = r % 64; XD_SET(p->in[I_WOUT] + (size_t)l * DM * DM, DM, 64 * kb, 32 * nb, 32, (bf16*)(wl + LW_OUT), DM, 32 * nb); }
    return d;
}
#undef XD_SET
__device__ __forceinline__ void ada_item(Frame& F, KParams p, int it) {
    const int l = it / 72, cg = it % 72;
    LAS float* cact = (LAS float*)F.lds;
    LAS float* red = (LAS float*)(F.lds + 65536);
    for (int idx = F.tid; idx < NB * DM; idx += 512) { const int b = idx & 7, k = idx >> 3; const float c = p->in[I_C][b * DM + k]; cact[idx] = c * __builtin_amdgcn_rcpf(1.0f + __expf(-c)); }
    __syncthreads();
    const float* W = p->in[I_WADA] + (size_t)l * DM * NMOD + cg * 256 + 4 * F.lane;
    f32x4 acc[8];
#pragma unroll
    for (int b = 0; b < 8; ++b) acc[b] = (f32x4){0.f, 0.f, 0.f, 0.f};
#pragma unroll 8
    for (int k = F.wave; k < DM; k += 8) {
        const f32x4 w = *(const f32x4*)(W + (size_t)k * NMOD);
        const f32x4 c0 = *(const LAS f32x4*)(cact + k * 8), c1 = *(const LAS f32x4*)(cact + k * 8 + 4);
        acc[0] += w * c0[0]; acc[1] += w * c0[1]; acc[2] += w * c0[2]; acc[3] += w * c0[3];
        acc[4] += w * c1[0]; acc[5] += w * c1[1]; acc[6] += w * c1[2]; acc[7] += w * c1[3];
    }
#pragma unroll
    for (int b = 0; b < 8; ++b) *(LAS f32x4*)(red + (F.wave * 8 + b) * 256 + 4 * F.lane) = acc[b];
    __syncthreads();
    { const int b = F.tid >> 6; f32x4 s = (f32x4){0.f, 0.f, 0.f, 0.f};
#pragma unroll
      for (int w = 0; w < 8; ++w) s += *(const LAS f32x4*)(red + (w * 8 + b) * 256 + 4 * F.lane);
      const int col = cg * 256 + 4 * F.lane;
      s += *(const f32x4*)(p->in[I_BADA] + (size_t)l * NMOD + col);
      *(f32x4*)((float*)(p->ws + WS_MOD) + (size_t)(l * NB + b) * NMOD + col) = s; }
}
__device__ __forceinline__ void p0_prologue(Frame& F, KParams p) {
    const int gt = F.vcu * 512 + F.tid, NGT = F.G * 512;
    for (int l = 0; l < NLAYER; ++l) {
        bf16* win = (bf16*)(p->ws + WS_W + (size_t)l * LW_BYTES + LW_IN); bf16* wuq = (bf16*)(p->ws + WS_W + (size_t)l * LW_BYTES + LW_UQ);
        for (int e = gt; e < 304 * (DM / 8); e += NGT) { int r = e / (DM / 8); const int c = e % (DM / 8);
            r = r < 48 ? 2640 + r : (r < 112 ? 3136 + (r - 48) : 3392 + (r - 112));
            *(v4u*)(win + (size_t)r * DM + 8 * c) = (v4u){0u, 0u, 0u, 0u}; }
        for (int e = gt; e < NQB * 8; e += NGT) *(v4u*)(wuq + (size_t)(e >> 3) * 512 + 448 + 8 * (e & 7)) = (v4u){0u, 0u, 0u, 0u};
    }
    { float* tab = (float*)(p->ws + WS_TAB);
      for (int e = gt; e < SEQ * 48; e += NGT) { const int t = e / 48, j = e % 48; const bool part = j < 16; const int i = part ? j : j - 16;
          const double r = part ? 0.44036660267178046 : 0.6636012376960885; double inv = 1.0; for (int q = 0; q < i; ++q) inv *= r;
          const float ang = (float)t * (float)inv; const double rev = (double)ang * 0.15915494309189535; const float fr = (float)(rev - floor(rev));
          const float cs = __builtin_amdgcn_cosf(fr), sn = __builtin_amdgcn_sinf(fr);
          if (part) { tab[t * 96 + i] = cs; tab[t * 96 + 16 + i] = sn; } else { tab[t * 96 + 32 + i] = cs; tab[t * 96 + 64 + i] = sn; } } }
    LAS float* scr = (LAS float*)(F.lds + F.wave * 16384);
    int it = q_next(F, 0);
    for (; it < ADA_ITEMS; it = q_next(F, 0)) ada_item(F, p, it);
#define XBLK(item, j) ((((item) - ADA_ITEMS) * 8 + F.wave) * XPW + (j))
    if (it < P0_ITEMS) {
        float va0[32], va1[32], vb0[32], vb1[32];
        XD a0 = xpose_desc(p, XBLK(it, 0)), a1 = xpose_desc(p, XBLK(it, 1)), b0, b1;
        xpose_load(a0, F.lane, va0); xpose_load(a1, F.lane, va1);
        for (;;) {
            int nx = q_next(F, 0);
            b0 = xpose_desc(p, XBLK(nx, 0)); b1 = xpose_desc(p, XBLK(nx, 1)); xpose_load(b0, F.lane, vb0); xpose_load(b1, F.lane, vb1);
            xpose_emit(a0, F.lane, va0, scr); xpose_emit(a1, F.lane, va1, scr);
            if (nx >= P0_ITEMS) break;
            nx = q_next(F, 0);
            a0 = xpose_desc(p, XBLK(nx, 0)); a1 = xpose_desc(p, XBLK(nx, 1)); xpose_load(a0, F.lane, va0); xpose_load(a1, F.lane, va1);
            xpose_emit(b0, F.lane, vb0, scr); xpose_emit(b1, F.lane, vb1, scr);
            if (nx >= P0_ITEMS) break;
        }
    }
#undef XBLK
}

__device__ __forceinline__ void norm_phase(Frame& F, const float* x, const float* g, const float* modl, int ch_shift, int ch_scale, bf16* H) {
    const int gw = F.vcu * NWAVES + F.wave, NGW = F.G * NWAVES;
    for (int m0 = gw * 16; m0 < M; m0 += NGW * 16) {
        const int b = m0 >> 12;
        const float* sh = modl + (size_t)b * NMOD + ch_shift * DM + 4 * F.lane; const float* sc = modl + (size_t)b * NMOD + ch_scale * DM + 4 * F.lane; const float* gg = g + 4 * F.lane;
        f32x4 av[8], tv[8];
#pragma unroll
        for (int j = 0; j < 8; ++j) { av[j] = *(const f32x4*)(gg + 256 * j) * (*(const f32x4*)(sc + 256 * j) + 1.0f); tv[j] = *(const f32x4*)(sh + 256 * j); }
        const float* xr = x + (size_t)m0 * DM + 4 * F.lane;
        f32x4 v[8], vn[8];
#pragma unroll
        for (int j = 0; j < 8; ++j) v[j] = *(const f32x4*)(xr + 256 * j);
#pragma unroll 1
        for (int r = 0; r < 16; ++r) {
            if (r + 1 < 16) {
#pragma unroll
                for (int j = 0; j < 8; ++j) vn[j] = *(const f32x4*)(xr + (size_t)(r + 1) * DM + 256 * j); }
            float ss = 0.f;
#pragma unroll
            for (int j = 0; j < 8; ++j) ss += (v[j][0] * v[j][0] + v[j][1] * v[j][1]) + (v[j][2] * v[j][2] + v[j][3] * v[j][3]);
            const float rstd = rsqrtf(wave_sum(ss) * (1.0f / DM) + NORM_EPS);
            bf16* hr = H + (size_t)(m0 + r) * DM + 4 * F.lane;
#pragma unroll
            for (int j = 0; j < 8; ++j) { const f32x4 h = v[j] * rstd * av[j] + tv[j]; v2u w; w.x = cvt_pk_bf16(h[0], h[1]); w.y = cvt_pk_bf16(h[2], h[3]); *(v2u*)(hr + 256 * j) = w; }
#pragma unroll
            for (int j = 0; j < 8; ++j) v[j] = vn[j];
        }
    }
}

__device__ __forceinline__ void unpack8(LAS float* y, v4u w) { *(LAS f32x4*)y = (f32x4){bf_lo(w.x), bf_hi(w.x), bf_lo(w.y), bf_hi(w.y)}; *(LAS f32x4*)(y + 4) = (f32x4){bf_lo(w.z), bf_hi(w.z), bf_lo(w.w), bf_hi(w.w)}; }
__device__ __forceinline__ v4u pack8(const LAS float* y) { const f32x4 a = *(const LAS f32x4*)y, b = *(const LAS f32x4*)(y + 4); v4u w; w.x = cvt_pk_bf16(a[0], a[1]); w.y = cvt_pk_bf16(a[2], a[3]); w.z = cvt_pk_bf16(b[0], b[1]); w.w = cvt_pk_bf16(b[2], b[3]); return w; }
template <int NG, int LEN, int GS> __device__ __forceinline__ void norm_pass(LAS float* y, int start, const LAS float* g, int lane) {
    constexpr int LPG = 64 / NG, EPL = LEN / LPG; static_assert(LEN % LPG == 0, "norm_pass");
    const int grp = lane / LPG, li = lane % LPG; LAS float* yb = y + start + grp * GS + li;
    float v[EPL]; float ss = 0.f;
#pragma unroll
    for (int j = 0; j < EPL; ++j) { v[j] = yb[LPG * j]; ss += v[j] * v[j]; }
    ss = xsum<LPG>(ss);
    const float rstd = rsqrtf(ss * (1.0f / LEN) + NORM_EPS);
#pragma unroll
    for (int j = 0; j < EPL; ++j) yb[LPG * j] = v[j] * rstd * g[li + LPG * j];
}
__device__ __forceinline__ int post1_col(int i) { return i < 64 ? PC_QA + 8 * i : (i < 128 ? PC_KA + 8 * (i - 64) : (i < 184 ? PC_CQ + 8 * (i - 128) : (i < 200 ? PC_CKV + 8 * (i - 184) : PC_KR + 8 * (i - 200)))); }
__device__ __forceinline__ void post1_phase(Frame& F, KParams p, int l) {
    bf16* P = (bf16*)(p->ws + WS_P); const float* tab = (const float*)(p->ws + WS_TAB);
    LAS float* y = (LAS float*)(F.lds + F.wave * 8192);
    LAS float* G = (LAS float*)(F.lds + 65536);
    for (int i = F.tid; i < 896; i += 512) G[i] = i < 128 ? p->in[I_GQA][l * 128 + i] : (i < 256 ? p->in[I_GKA][l * 128 + i - 128] : (i < 704 ? p->in[I_GCQ][l * 448 + i - 256] : (i < 832 ? p->in[I_GCKV][l * 128 + i - 704] : p->in[I_GKR][l * 64 + i - 832])));
    __syncthreads();
    const int gw = F.vcu * NWAVES + F.wave, NGW = F.G * NWAVES, lane = F.lane;
    const int c1 = post1_col(lane + 64), c2 = post1_col(lane + 128), c3 = post1_col(lane < 16 ? lane + 192 : 192);
    v4u r1, r2, r3;
#define P1LOAD(m_) do { const bf16* row_ = P + (size_t)(m_) * NP; r1 = *(const v4u*)(row_ + c1); r2 = *(const v4u*)(row_ + c2); r3 = *(const v4u*)(row_ + c3); } while (0)
    if (gw < M) P1LOAD(gw);
    for (int m = gw; m < M; m += NGW) {
        const int t = m & (SEQ - 1); bf16* row = P + (size_t)m * NP;
        unpack8(y + 8 * (lane + 64), r1); unpack8(y + 8 * (lane + 128), r2); if (lane < 16) unpack8(y + 8 * (lane + 192), r3);
        const float* tb = tab + (size_t)t * 96;
        float rc[2], rs[2]; { const int i = lane & 15; rc[0] = tb[i]; rs[0] = tb[16 + i]; rc[1] = tb[32 + (lane & 31)]; rs[1] = tb[64 + (lane & 31)]; }
        if (m + NGW < M) P1LOAD(m + NGW);
        LDS_WAIT(); asm volatile("" ::: "memory");
        norm_pass<4, 128, 128>(y, 512, G + 128, lane); norm_pass<1, 448, 0>(y, 1024, G + 256, lane);
        {
          const int hf = lane >> 5, li = lane & 31; LAS float* yb = y + (hf ? 1600 : 1472) + li; const LAS float* gb = G + (hf ? 832 : 704) + li;
          const float v0 = yb[0], v1 = yb[32], v2 = hf ? 0.f : yb[64], v3 = hf ? 0.f : yb[96]; float ss = (v0 * v0 + v1 * v1) + (v2 * v2 + v3 * v3);
          ss = xsum<32>(ss);
          const float rstd = rsqrtf(ss * (hf ? 1.0f / 64 : 1.0f / 128) + NORM_EPS);
          yb[0] = v0 * rstd * gb[0]; yb[32] = v1 * rstd * gb[32]; if (!hf) { yb[64] = v2 * rstd * gb[64]; yb[96] = v3 * rstd * gb[96]; } }
        LDS_WAIT(); asm volatile("" ::: "memory");
#pragma unroll
        for (int k = 1; k < 2; ++k) { const int pr = lane + 64 * k, base = 128 * (pr >> 4), i = pr & 15; const float a = y[base + i], b = y[base + 16 + i], c = rc[0], s = rs[0];
            y[base + i] = a * c - b * s; y[base + 16 + i] = a * s + b * c; }
        if (lane < 32) { const float a = y[1600 + lane], b = y[1632 + lane], c = rc[1], s = rs[1]; y[1600 + lane] = a * c - b * s; y[1632 + lane] = a * s + b * c; }
        LDS_WAIT(); asm volatile("" ::: "memory");
        *(v4u*)(row + c1) = pack8(y + 8 * (lane + 64)); *(v4u*)(row + c2) = pack8(y + 8 * (lane + 128)); if (lane < 16) *(v4u*)(row + c3) = pack8(y + 8 * (lane + 192));
        LDS_WAIT(); asm volatile("" ::: "memory");
    }
#undef P1LOAD
}

namespace att {
constexpr int QBLK = 32, KVBLK = 64;
constexpr int SHM_V = 16384, SHM_K = 16384, SHM_KR = 8192;
constexpr int OFF_V = 0, OFF_K = 2 * SHM_V, OFF_KR = OFF_K + 2 * SHM_K, OFF_WS = OFF_KR + 2 * SHM_KR, OFF_QR = OFF_WS + NWAVES * 64 * 4, OFF_DONE = OFF_QR + NWAVES * 4096, SHM_ATTN = OFF_DONE + 16;
constexpr float L2E = 1.4426950408889634f;
#define KSWZ(row, colB) ((row) * 256 + ((colB) ^ (((row) & 7) << 4)))
#define KRSWZ(row, colB) ((row) * 128 + ((colB) ^ (((row) & 7) << 4)))
__device__ __forceinline__ int crow(int r, int hi) { return (r & 3) + 8 * (r >> 2) + 4 * hi; }
#ifndef ATT_PIPE_A
#define ATT_PIPE_A true
#endif
#ifndef ATT_SD_A
#define ATT_SD_A 2
#endif
#ifndef ATT_SD_B
#define ATT_SD_B 1
#endif
#ifndef ATT_PIPE_B
#define ATT_PIPE_B true
#endif
#ifndef ATT_PIPE_C
#define ATT_PIPE_C false
#endif
template <int MODE> struct Cfg;
template <> struct Cfg<0> { static constexpr float SCALE = 0.088388347648318440f; static constexpr int ND0 = 8, SDEPTH = ATT_SD_A; static constexpr bool PIPE = ATT_PIPE_A; };
template <> struct Cfg<1> { static constexpr float SCALE = 0.072168783648703220f; static constexpr int ND0 = 12, SDEPTH = ATT_SD_B; static constexpr bool PIPE = ATT_PIPE_B; };
template <> struct Cfg<2> { static constexpr float SCALE = 0.088388347648318440f; static constexpr int ND0 = 8, SDEPTH = 1; static constexpr bool PIPE = ATT_PIPE_C; };
constexpr float THR = 8.f;
template <int MODE> __device__ __forceinline__ void partialSM(f32x16& p0, f32x16& p1, float& m_reg, float& mn, float& alpha) {
    constexpr float SCALE = Cfg<MODE>::SCALE, C = SCALE * L2E;
    float pmax = p0[0];
#pragma unroll
    for (int r = 1; r < 16; ++r) pmax = fmaxf(pmax, p0[r]);
#pragma unroll
    for (int r = 0; r < 16; ++r) pmax = fmaxf(pmax, p1[r]);
    { auto rr = __builtin_amdgcn_permlane32_swap(__float_as_uint(pmax), __float_as_uint(pmax), false, false); pmax = fmaxf(__uint_as_float(rr[0]), __uint_as_float(rr[1])); }
    if (__builtin_expect(__all(pmax - m_reg <= THR / SCALE), 1)) { mn = m_reg; alpha = 1.f; }
    else { mn = fmaxf(m_reg, pmax); alpha = __builtin_amdgcn_exp2f((m_reg - mn) * C); m_reg = mn; }
    const float mnC = -mn * C;
#pragma unroll
    for (int r = 0; r < 16; ++r) p0[r] = fmaf(p0[r], C, mnC);
#pragma unroll
    for (int r = 0; r < 16; ++r) p1[r] = fmaf(p1[r], C, mnC);
#pragma unroll
    for (int r = 0; r < 16; ++r) p0[r] = __builtin_amdgcn_exp2f(p0[r]);
}
#define PK4(P, BASE, OUT) do { unsigned a0 = cvt_pk_bf16(P[BASE + 0], P[BASE + 1]), a1 = cvt_pk_bf16(P[BASE + 2], P[BASE + 3]);   \
    unsigned b0 = cvt_pk_bf16(P[BASE + 4], P[BASE + 5]), b1 = cvt_pk_bf16(P[BASE + 6], P[BASE + 7]);                              \
    auto r0 = __builtin_amdgcn_permlane32_swap(a0, b0, false, false); auto r1 = __builtin_amdgcn_permlane32_swap(a1, b1, false, false); \
    v4u w = {r0[0], r1[0], r0[1], r1[1]}; OUT = *reinterpret_cast<bf16x8*>(&w); } while (0)
__device__ __forceinline__ void finishSM(f32x16& p0, f32x16& p1, float alpha, float& l_reg, bf16x8& pa0, bf16x8& pa1, bf16x8& pa2, bf16x8& pa3) {
#pragma unroll
    for (int r = 0; r < 16; ++r) p1[r] = __builtin_amdgcn_exp2f(p1[r]);
    float ps = 0;
#pragma unroll
    for (int r = 0; r < 16; ++r) ps += p0[r];
#pragma unroll
    for (int r = 0; r < 16; ++r) ps += p1[r];
    { auto rr = __builtin_amdgcn_permlane32_swap(__float_as_uint(ps), __float_as_uint(ps), false, false); ps = __uint_as_float(rr[0]) + __uint_as_float(rr[1]); }
    l_reg = l_reg * alpha + ps;
    PK4(p0, 0, pa0); PK4(p0, 8, pa1); PK4(p1, 0, pa2); PK4(p1, 8, pa3);
}
__device__ __forceinline__ void packP(f32x16& p0, f32x16& p1, bf16x8& pa0, bf16x8& pa1, bf16x8& pa2, bf16x8& pa3) { PK4(p0, 0, pa0); PK4(p0, 8, pa1); PK4(p1, 0, pa2); PK4(p1, 8, pa3); }
__device__ __forceinline__ void stick_half(f32x16& p, const int cbase, const float Rin, float& T, const int lim2, const int hi, const float f0) {
    constexpr float SC = 0.088388347648318440f;
    float ls[16];
#pragma unroll
    for (int r = 0; r < 16; ++r) { const int c = (r & 3) + 8 * (r >> 2) + cbase;
        const float z = p[r] * SC; const float e = __builtin_amdgcn_exp2f(-fabsf(z) * L2E); const float sp = fmaxf(z, 0.f) + __builtin_amdgcn_logf(1.0f + e) * 0.6931471805599453f;
        p[r] = z; ls[r] = (c < lim2) ? -sp : 0.f; }
    float own[4], oth[4];
#pragma unroll
    for (int i = 0; i < 4; ++i) own[i] = (ls[4 * i] + ls[4 * i + 1]) + (ls[4 * i + 2] + ls[4 * i + 3]);
#pragma unroll
    for (int i = 0; i < 4; ++i) { auto rr = __builtin_amdgcn_permlane32_swap(__float_as_uint(own[i]), __float_as_uint(own[i]), false, false); oth[i] = hi ? __uint_as_float(rr[0]) : __uint_as_float(rr[1]); }
#pragma unroll
    for (int i = 3; i >= 0; --i) {
        const float l3 = Rin + T + oth[i] * f0;
        const int b = 4 * i, cb = 8 * i + cbase;
        const float l2 = l3 + ls[b + 3], l1 = l2 + ls[b + 2], l0 = l1 + ls[b + 1];
        p[b + 3] = (cb + 3 < lim2) ? __builtin_amdgcn_exp2f((p[b + 3] + ls[b + 3] + l3) * L2E) : 0.f; p[b + 2] = (cb + 2 < lim2) ? __builtin_amdgcn_exp2f((p[b + 2] + ls[b + 2] + l2) * L2E) : 0.f;
        p[b + 1] = (cb + 1 < lim2) ? __builtin_amdgcn_exp2f((p[b + 1] + ls[b + 1] + l1) * L2E) : 0.f; p[b + 0] = (cb + 0 < lim2) ? __builtin_amdgcn_exp2f((p[b + 0] + ls[b + 0] + l0) * L2E) : 0.f;
        T += own[i] + oth[i];
    }
}
__device__ __forceinline__ void stickSM(f32x16& p0, f32x16& p1, float& R, int lim2, int hi) {
    const float f0 = hi ? 0.f : 1.f; float T = 0.f;
    stick_half(p1, 32, R, T, lim2, hi, f0); asm volatile("" : "+v"(T));
    stick_half(p0, 0, R, T, lim2, hi, f0);
    R += T;
}
__device__ __forceinline__ void maskA(f32x16& p0, f32x16& p1, unsigned w0, unsigned w1, int hi) {
    const unsigned a = w0 >> (4 * hi), b = w1 >> (4 * hi);
#pragma unroll
    for (int r = 0; r < 16; ++r) { const unsigned bit = 1u << ((r & 3) + 8 * (r >> 2)); p0[r] = (a & bit) ? p0[r] : -INFINITY; p1[r] = (b & bit) ? p1[r] : -INFINITY; }
}
template <int ND0> __device__ __forceinline__ void qkt(f32x16& p0, f32x16& p1, const char* Ks, const char* Krs, const bf16x8* qr, const char* qrl, int r32, int hi) {
    p0 = f32x16{}; p1 = f32x16{};
#pragma unroll
    for (int d0 = 0; d0 < 8; ++d0) { const int cb = (d0 * 16 + hi * 8) * 2;
        const bf16x8 b0 = *reinterpret_cast<const bf16x8*>(Ks + KSWZ(r32, cb)), b1 = *reinterpret_cast<const bf16x8*>(Ks + KSWZ(32 + r32, cb));
        p0 = __builtin_amdgcn_mfma_f32_32x32x16_bf16(b0, qr[d0], p0, 0, 0, 0); p1 = __builtin_amdgcn_mfma_f32_32x32x16_bf16(b1, qr[d0], p1, 0, 0, 0); }
    if constexpr (ND0 == 12) {
#pragma unroll
        for (int d0 = 0; d0 < 4; ++d0) { const int cb = (d0 * 16 + hi * 8) * 2;
            const bf16x8 b0 = *reinterpret_cast<const bf16x8*>(Krs + KRSWZ(r32, cb)), b1 = *reinterpret_cast<const bf16x8*>(Krs + KRSWZ(32 + r32, cb));
            const bf16x8 qv = *reinterpret_cast<const bf16x8*>(qrl + d0 * 1024);
            p0 = __builtin_amdgcn_mfma_f32_32x32x16_bf16(b0, qv, p0, 0, 0, 0); p1 = __builtin_amdgcn_mfma_f32_32x32x16_bf16(b1, qv, p1, 0, 0, 0); } }
}
__device__ __forceinline__ int v_st(int k, int c) { const int kk = (k & ~0xC) | ((k & 4) << 1) | ((k & 8) >> 1); return ((kk >> 3) * 4 + (c >> 5)) * 512 + ((kk & 7) * 32 + (c & 31)) * 2; }
__device__ __forceinline__ int v_rd_base(int lane) { return ((lane & 3) << 3) | (((lane >> 2) & 3) << 6) | (((lane >> 4) & 1) << 5) | (((lane >> 5) & 1) << 8); }
constexpr int v_rd_off(int d0, int ks, int half) { return d0 * 512 + ks * 4096 + half * 2048; }
template <int OFF> __device__ __forceinline__ s16x4 tr_read(int vb) { s16x4 r; asm volatile("ds_read_b64_tr_b16 %0, %1 offset:%2" : "=&v"(r) : "v"(vb), "i"(OFF) : "memory"); return r; }
template <int D0> __device__ __forceinline__ void pv_one(f32x16& od, int vb, bf16x8 pa0, bf16x8 pa1, bf16x8 pa2, bf16x8 pa3) {
    const s16x4 l0 = tr_read<v_rd_off(D0, 0, 0)>(vb), h0 = tr_read<v_rd_off(D0, 0, 1)>(vb), l1 = tr_read<v_rd_off(D0, 1, 0)>(vb), h1 = tr_read<v_rd_off(D0, 1, 1)>(vb);
    const s16x4 l2 = tr_read<v_rd_off(D0, 2, 0)>(vb), h2 = tr_read<v_rd_off(D0, 2, 1)>(vb), l3 = tr_read<v_rd_off(D0, 3, 0)>(vb), h3 = tr_read<v_rd_off(D0, 3, 1)>(vb);
    asm volatile("s_waitcnt lgkmcnt(0)" ::: "memory"); SBAR();
#define PKV(L, H) (bf16x8){L[0], L[1], L[2], L[3], H[0], H[1], H[2], H[3]}
    od = __builtin_amdgcn_mfma_f32_32x32x16_bf16(pa0, PKV(l0, h0), od, 0, 0, 0);
    od = __builtin_amdgcn_mfma_f32_32x32x16_bf16(pa1, PKV(l1, h1), od, 0, 0, 0);
    od = __builtin_amdgcn_mfma_f32_32x32x16_bf16(pa2, PKV(l2, h2), od, 0, 0, 0);
    od = __builtin_amdgcn_mfma_f32_32x32x16_bf16(pa3, PKV(l3, h3), od, 0, 0, 0);
#undef PKV
}
__device__ __forceinline__ void pv_d0(f32x16* o, int vb, bf16x8 pa0, bf16x8 pa1, bf16x8 pa2, bf16x8 pa3) {
    pv_one<0>(o[0], vb, pa0, pa1, pa2, pa3); pv_one<1>(o[1], vb, pa0, pa1, pa2, pa3); pv_one<2>(o[2], vb, pa0, pa1, pa2, pa3); pv_one<3>(o[3], vb, pa0, pa1, pa2, pa3);
}

template <int MODE>
__device__ __forceinline__ void attn_unit(const bf16* __restrict__ Qb, int ldq, const bf16* __restrict__ Kh, const bf16* __restrict__ Vh, int ldk, const bf16* __restrict__ Krh,
                                          bf16* __restrict__ Ob, int ldo, int NT, int t0, const unsigned* __restrict__ mrow, char* lds, int wv,
                                          const float* __restrict__ gqn = nullptr, const float* __restrict__ gqr = nullptr, const float* __restrict__ tab = nullptr) {
    constexpr int ND0 = Cfg<MODE>::ND0, SDEPTH = Cfg<MODE>::SDEPTH;
    int wv_ = wv; asm volatile("" : "+s"(wv_)); int tid_ = (wv_ << 6) | lane_id_fresh(); tid_ &= 511;
    const int tid = tid_, wid = tid >> 6, lane = tid & 63, r32 = lane & 31, hi = lane >> 5;
    if (wv_ >= 4) __builtin_amdgcn_s_setprio(1);
    char* V_lds = lds + OFF_V; char* K_lds = lds + OFF_K; char* KR_lds = lds + OFF_KR;
    float* ws = (float*)(lds + OFF_WS) + wid * 64; float* li_l = ws; float* al_l = ws + 32;
    float m_reg = -1e30f, l_reg = 0.f, R = 0.f; f32x16 o[4] = {}; bf16x8 qr[8];
    const bf16* Qw = Qb + (size_t)(wid * QBLK + r32) * ldq + hi * 8;
    char* qrl = lds + OFF_QR + wid * 4096 + lane * 16;
    if constexpr (MODE == 0 || MODE == 1) {
        float qf[8][8]; float ss = 0.f;
#pragma unroll
        for (int d0 = 0; d0 < 8; ++d0) { const v4u w = *reinterpret_cast<const v4u*>(Qw + d0 * 16);
            qf[d0][0] = bf_lo(w.x); qf[d0][1] = bf_hi(w.x); qf[d0][2] = bf_lo(w.y); qf[d0][3] = bf_hi(w.y); qf[d0][4] = bf_lo(w.z); qf[d0][5] = bf_hi(w.z); qf[d0][6] = bf_lo(w.w); qf[d0][7] = bf_hi(w.w); }
#pragma unroll
        for (int d0 = 0; d0 < 8; ++d0)
#pragma unroll
            for (int j = 0; j < 8; ++j) ss += qf[d0][j] * qf[d0][j];
        { auto r = __builtin_amdgcn_permlane32_swap(__float_as_uint(ss), __float_as_uint(ss), false, false); ss = __uint_as_float(r[0]) + __uint_as_float(r[1]); }
        const float rstd = rsqrtf(ss * (1.0f / 128) + NORM_EPS);
        const float* tb = tab + (size_t)(t0 + wid * QBLK + r32) * 96;
#pragma unroll
        for (int d0 = 0; d0 < 8; ++d0) { const f32x4 g0 = *reinterpret_cast<const f32x4*>(gqn + d0 * 16 + hi * 8), g1 = *reinterpret_cast<const f32x4*>(gqn + d0 * 16 + hi * 8 + 4);
#pragma unroll
            for (int j = 0; j < 4; ++j) { qf[d0][j] = qf[d0][j] * rstd * g0[j]; qf[d0][4 + j] = qf[d0][4 + j] * rstd * g1[j]; } }
        if constexpr (MODE == 0) {
            const int i0 = hi * 8;
            const f32x4 c0 = *reinterpret_cast<const f32x4*>(tb + i0), c1 = *reinterpret_cast<const f32x4*>(tb + i0 + 4), s0 = *reinterpret_cast<const f32x4*>(tb + 16 + i0), s1 = *reinterpret_cast<const f32x4*>(tb + 16 + i0 + 4);
#pragma unroll
            for (int j = 0; j < 8; ++j) { const float c = j < 4 ? c0[j & 3] : c1[j & 3], s = j < 4 ? s0[j & 3] : s1[j & 3], a = qf[0][j], b = qf[1][j];
                qf[0][j] = a * c - b * s; qf[1][j] = a * s + b * c; }
        }
#pragma unroll
        for (int d0 = 0; d0 < 8; ++d0) { v4u w; w.x = cvt_pk_bf16(qf[d0][0], qf[d0][1]); w.y = cvt_pk_bf16(qf[d0][2], qf[d0][3]); w.z = cvt_pk_bf16(qf[d0][4], qf[d0][5]); w.w = cvt_pk_bf16(qf[d0][6], qf[d0][7]);
            qr[d0] = *reinterpret_cast<bf16x8*>(&w); }
        if constexpr (MODE == 1) {
            float rf[4][8]; float s2 = 0.f;
#pragma unroll
            for (int d0 = 0; d0 < 4; ++d0) { const v4u w = *reinterpret_cast<const v4u*>(Qw + (8 + d0) * 16);
                rf[d0][0] = bf_lo(w.x); rf[d0][1] = bf_hi(w.x); rf[d0][2] = bf_lo(w.y); rf[d0][3] = bf_hi(w.y); rf[d0][4] = bf_lo(w.z); rf[d0][5] = bf_hi(w.z); rf[d0][6] = bf_lo(w.w); rf[d0][7] = bf_hi(w.w); }
#pragma unroll
            for (int d0 = 0; d0 < 4; ++d0)
#pragma unroll
                for (int j = 0; j < 8; ++j) s2 += rf[d0][j] * rf[d0][j];
            { auto r = __builtin_amdgcn_permlane32_swap(__float_as_uint(s2), __float_as_uint(s2), false, false); s2 = __uint_as_float(r[0]) + __uint_as_float(r[1]); }
            const float rstd2 = rsqrtf(s2 * (1.0f / 64) + NORM_EPS);
#pragma unroll
            for (int d0 = 0; d0 < 4; ++d0) { const f32x4 g0 = *reinterpret_cast<const f32x4*>(gqr + d0 * 16 + hi * 8), g1 = *reinterpret_cast<const f32x4*>(gqr + d0 * 16 + hi * 8 + 4);
#pragma unroll
                for (int j = 0; j < 4; ++j) { rf[d0][j] = rf[d0][j] * rstd2 * g0[j]; rf[d0][4 + j] = rf[d0][4 + j] * rstd2 * g1[j]; } }
#pragma unroll
            for (int d0 = 0; d0 < 2; ++d0) { const int i0 = d0 * 16 + hi * 8;
                const f32x4 c0 = *reinterpret_cast<const f32x4*>(tb + 32 + i0), c1 = *reinterpret_cast<const f32x4*>(tb + 32 + i0 + 4), s0 = *reinterpret_cast<const f32x4*>(tb + 64 + i0), s1 = *reinterpret_cast<const f32x4*>(tb + 64 + i0 + 4);
#pragma unroll
                for (int j = 0; j < 8; ++j) { const float c = j < 4 ? c0[j & 3] : c1[j & 3], s = j < 4 ? s0[j & 3] : s1[j & 3], a = rf[d0][j], b = rf[d0 + 2][j];
                    rf[d0][j] = a * c - b * s; rf[d0 + 2][j] = a * s + b * c; } }
#pragma unroll
            for (int d0 = 0; d0 < 4; ++d0) { v4u w; w.x = cvt_pk_bf16(rf[d0][0], rf[d0][1]); w.y = cvt_pk_bf16(rf[d0][2], rf[d0][3]); w.z = cvt_pk_bf16(rf[d0][4], rf[d0][5]); w.w = cvt_pk_bf16(rf[d0][6], rf[d0][7]);
                *reinterpret_cast<v4u*>(qrl + d0 * 1024) = w; }
        }
    } else {
#pragma unroll
        for (int d0 = 0; d0 < 8; ++d0) qr[d0] = *reinterpret_cast<const bf16x8*>(Qw + d0 * 16);
    }
    const int sr = tid >> 4, sc = (tid & 15) * 8, vst0 = v_st(sr, sc), vst1 = v_st(32 + sr, sc);
    const int krr = tid >> 3, krc = (tid & 7) * 8;
    const int vb0 = (int)(uintptr_t)V_lds + v_rd_base(lane);
    const int cw = (t0 >> 6) + (wid >> 1);
    const unsigned* mlane = mrow + (size_t)(wid * QBLK + r32) * 128;
    struct { bf16x8 vs0, vs1, ks0, ks1, kr; } sr_[SDEPTH];
#define TILE(j) (MODE == 2 ? (NT - 1 - (j)) : (j))
#define SLOAD(i, j) do { const int k0_ = TILE(j) * KVBLK; sr_[i].vs0 = *reinterpret_cast<const bf16x8*>(&Vh[(size_t)(k0_ + sr) * ldk + sc]); sr_[i].vs1 = *reinterpret_cast<const bf16x8*>(&Vh[(size_t)(k0_ + 32 + sr) * ldk + sc]); \
    sr_[i].ks0 = *reinterpret_cast<const bf16x8*>(&Kh[(size_t)(k0_ + sr) * ldk + sc]); sr_[i].ks1 = *reinterpret_cast<const bf16x8*>(&Kh[(size_t)(k0_ + 32 + sr) * ldk + sc]); \
    if constexpr (MODE == 1) sr_[i].kr = *reinterpret_cast<const bf16x8*>(&Krh[(size_t)(k0_ + krr) * NP + krc]); } while (0)
#define SWRITE(b, i) do { *(bf16x8*)(V_lds + (b) * SHM_V + vst0) = sr_[i].vs0; *(bf16x8*)(V_lds + (b) * SHM_V + vst1) = sr_[i].vs1; const int kc_ = sc * 2;   \
    *(bf16x8*)(K_lds + (b) * SHM_K + KSWZ(sr, kc_)) = sr_[i].ks0; *(bf16x8*)(K_lds + (b) * SHM_K + KSWZ(32 + sr, kc_)) = sr_[i].ks1;               \
    if constexpr (MODE == 1) *(bf16x8*)(KR_lds + (b) * SHM_KR + KRSWZ(krr, krc * 2)) = sr_[i].kr; } while (0)
#define SWAIT() do { if constexpr (SDEPTH == 2) asm volatile("s_waitcnt vmcnt(4)" ::: "memory"); else asm volatile("s_waitcnt vmcnt(0)" ::: "memory"); } while (0)
#define RESC(a) do { if constexpr (MODE != 2) { if (__any((a) < 1.f)) { if (hi == 0) al_l[r32] = (a); asm volatile("s_waitcnt lgkmcnt(0)" ::: "memory"); \
    _Pragma("unroll") for (int d = 0; d < 4; ++d) _Pragma("unroll") for (int r = 0; r < 16; ++r) o[d][r] *= al_l[crow(r, hi)]; } } } while (0)
#define MLOAD(w0, w1, j) do { if constexpr (MODE == 0) { const v2u mw_ = *reinterpret_cast<const v2u*>(mlane + 2 * TILE(j)); w0 = mw_.x; w1 = mw_.y; } } while (0)
#define PART(P0, P1, MN, AL, w0, w1, j) do { const int jj_ = TILE(j); \
    if constexpr (MODE == 0) { maskA(P0, P1, w0, w1, hi); partialSM<0>(P0, P1, m_reg, MN, AL); } \
    else if constexpr (MODE == 1) { if (jj_ > cw) { _Pragma("unroll") for (int r = 0; r < 16; ++r) { P0[r] = -INFINITY; P1[r] = -INFINITY; } } partialSM<1>(P0, P1, m_reg, MN, AL); } \
    else { const int lim_ = jj_ < cw ? 64 : (jj_ > cw ? 0 : 32 * (wid & 1) + r32); stickSM(P0, P1, R, lim_ - 4 * hi, hi); } } while (0)
#define FIN(P0, P1, AL) do { if constexpr (MODE == 2) packP(P0, P1, pa0, pa1, pa2, pa3); else finishSM(P0, P1, AL, l_reg, pa0, pa1, pa2, pa3); } while (0)
    f32x16 pA0, pA1; float mnA = 0.f, alA = 1.f; bf16x8 pa0, pa1, pa2, pa3; unsigned mA0 = 0, mA1 = 0;
    (void)mnA;
    if constexpr (!Cfg<MODE>::PIPE) {
    volatile LAS unsigned* dn = (volatile LAS unsigned*)(lds + OFF_DONE); int ds = 0;
    if constexpr (MODE == 2) { if (tid < 3) dn[tid] = 0u; }
    SLOAD(0, 0); asm volatile("s_waitcnt vmcnt(0)" ::: "memory"); SWRITE(0, 0); __syncthreads();
    for (int j = 0; j < NT; ++j) {
        const int buf = j & 1;
        MLOAD(mA0, mA1, j);
        if (j + 1 < NT) SLOAD(0, j + 1);
        SBAR();
        qkt<ND0>(pA0, pA1, K_lds + buf * SHM_K, KR_lds + buf * SHM_KR, qr, qrl, r32, hi);
        PART(pA0, pA1, mnA, alA, mA0, mA1, j);
        FIN(pA0, pA1, alA);
        RESC(alA);
        SBAR();
        pv_d0(o, vb0 + buf * SHM_V, pa0, pa1, pa2, pa3);
        if (j + 1 < NT) { asm volatile("s_waitcnt vmcnt(0)" ::: "memory"); SWRITE(buf ^ 1, 0); }
        if constexpr (MODE == 2) { if (__all(R < -120.f) && lane == 0) __hip_atomic_fetch_add((LAS unsigned*)(lds + OFF_DONE) + ds, 1u, __ATOMIC_RELAXED, __HIP_MEMORY_SCOPE_WORKGROUP); }
        __syncthreads();
        if constexpr (MODE == 2) { const unsigned c_ = dn[ds]; const int zs = ds == 0 ? 2 : ds - 1; if (tid == 0) dn[zs] = 0u; ds = ds == 2 ? 0 : ds + 1; if (c_ == NWAVES) break; }
    }
    } else {
    f32x16 pB0, pB1; float mnB = 0.f, alB = 1.f; unsigned mB0 = 0, mB1 = 0; (void)mnB;
    constexpr int SE = 0, SO = SDEPTH - 1;
    SLOAD(SE, 0); MLOAD(mA0, mA1, 0); asm volatile("s_waitcnt vmcnt(0)" ::: "memory"); SWRITE(0, SE); __syncthreads();
    qkt<ND0>(pA0, pA1, K_lds, KR_lds, qr, qrl, r32, hi); PART(pA0, pA1, mnA, alA, mA0, mA1, 0);
    SLOAD(SO, 1); if constexpr (SDEPTH == 2) { if (2 < NT) SLOAD(SE, 2); }
    SWAIT(); SWRITE(1, SO); __syncthreads();
    for (int j = 1; j + 1 < NT; j += 2) {
        SBAR(); MLOAD(mB0, mB1, j); qkt<ND0>(pB0, pB1, K_lds + SHM_K, KR_lds + SHM_KR, qr, qrl, r32, hi);
        FIN(pA0, pA1, alA); SBAR();
        SLOAD(SO, j + SDEPTH); SBAR();
        pv_d0(o, vb0, pa0, pa1, pa2, pa3); PART(pB0, pB1, mnB, alB, mB0, mB1, j);
        __syncthreads(); SWAIT(); SWRITE(0, SE);
        RESC(alB); __syncthreads();
        SBAR(); MLOAD(mA0, mA1, j + 1); qkt<ND0>(pA0, pA1, K_lds, KR_lds, qr, qrl, r32, hi);
        FIN(pB0, pB1, alB); SBAR();
        if (SDEPTH == 1 || j + 3 < NT) SLOAD(SE, j + 1 + SDEPTH); SBAR();
        pv_d0(o, vb0 + SHM_V, pa0, pa1, pa2, pa3); PART(pA0, pA1, mnA, alA, mA0, mA1, j + 1);
        __syncthreads(); SWAIT(); SWRITE(1, SO);
        RESC(alA); __syncthreads();
    }
    SBAR(); MLOAD(mB0, mB1, NT - 1); qkt<ND0>(pB0, pB1, K_lds + SHM_K, KR_lds + SHM_KR, qr, qrl, r32, hi);
    FIN(pA0, pA1, alA); SBAR();
    pv_d0(o, vb0, pa0, pa1, pa2, pa3); PART(pB0, pB1, mnB, alB, mB0, mB1, NT - 1);
    __syncthreads(); RESC(alB);
    FIN(pB0, pB1, alB); SBAR();
    pv_d0(o, vb0 + SHM_V, pa0, pa1, pa2, pa3);
    __syncthreads();
    }
    float rli[16];
    if constexpr (MODE != 2) { if (hi == 0) li_l[r32] = l_reg; asm volatile("s_waitcnt lgkmcnt(0)" ::: "memory");
#pragma unroll
        for (int r = 0; r < 16; ++r) rli[r] = __builtin_amdgcn_rcpf(li_l[crow(r, hi)]); }
    else {
#pragma unroll
        for (int r = 0; r < 16; ++r) rli[r] = 1.f; }
    bf16* Ow = Ob + (size_t)(wid * QBLK) * ldo;
    LAS unsigned char* ot = (LAS unsigned char*)lds + wid * 8192;
#pragma unroll
    for (int r = 0; r < 16; ++r) { const int orow = crow(r, hi);
#pragma unroll
        for (int d0 = 0; d0 < 4; ++d0) *(LAS bf16*)(ot + orow * 256 + (d0 * 32 + r32) * 2) = (bf16)(cvt_pk_bf16(o[d0][r] * rli[r], 0.f) & 0xffffu); }
    asm volatile("s_waitcnt lgkmcnt(0)" ::: "memory");
#pragma unroll
    for (int k = 0; k < 8; ++k) { const int row = 4 * k + (lane >> 4), cp = lane & 15;
        const v4u v = *(const LAS v4u*)(ot + row * 256 + cp * 16); *(v4u*)(Ow + (size_t)row * ldo + cp * 8) = v; }
    __builtin_amdgcn_s_setprio(0);
    __syncthreads();
#undef TILE
#undef SLOAD
#undef SWRITE
#undef SWAIT
#undef RESC
#undef MLOAD
#undef PART
#undef FIN
}
}

__device__ __forceinline__ unsigned ordkey(float f) { const unsigned u = __float_as_uint(f); return u ^ ((unsigned)((int)u >> 31) | 0x80000000u); }
__device__ __forceinline__ unsigned keyinv(unsigned k) { return k ^ ((unsigned)(~((int)k >> 31)) | 0x80000000u); }
__device__ __forceinline__ void indexer_unit(KParams p, int b, int u16, LAS unsigned char* lds, int tid) {
    const int wave = __builtin_amdgcn_readfirstlane(tid >> 6), lane = tid & 63, r32 = lane & 31, hi = lane >> 5;
    const int t0 = 16 * u16, m0 = b * SEQ + t0, c = t0 >> 6, ng = 2 * (c + 1), ntile = (ng + 7) >> 3;
    const bf16* P = (const bf16*)(p->ws + WS_P); const bf16* KI = P + (size_t)b * SEQ * NP + PC_KI; unsigned* MASK = (unsigned*)(p->ws + WS_MASK);
    bf16x8 aq[4];
    { const bf16* qp = P + (size_t)(m0 + 2 * wave + (r32 >> 4)) * NP + PC_QI + (r32 & 15) * 64 + 8 * hi;
#pragma unroll
      for (int s = 0; s < 4; ++s) aq[s] = *reinterpret_cast<const bf16x8*>(qp + 16 * s); }
    float wv[16];
#pragma unroll
    for (int r = 0; r < 16; ++r) { const int q = r >> 3, h = (r & 3) + 8 * ((r >> 2) & 1) + 4 * hi; wv[r] = __uint_as_float((unsigned)P[(size_t)(m0 + 2 * wave + q) * NP + PC_WI + h] << 16) * 0.03125f; }
    unsigned kx[128];
#pragma unroll
    for (int g = 0; g < 128; ++g) kx[g] = 0u;
    const int dkey = lane >> 3, dslot = lane & 7;
#define ILOAD(T, buf) do { _Pragma("unroll") for (int k = 0; k < 4; ++k) { const int key = 32 * wave + 8 * k + dkey; \
        __builtin_amdgcn_global_load_lds((const unsigned*)(KI + (size_t)((T) * 256 + key) * NP + 8 * (dslot ^ ((key >> 1) & 7))), (LAS unsigned*)(lds + (buf) * 32768 + 4096 * wave + 1024 * k), 16, 0, 0); } } while (0)
    ILOAD(0, 0);
    if (ntile > 1) { ILOAD(1, 1); asm volatile("s_waitcnt vmcnt(4)" ::: "memory"); } else { asm volatile("s_waitcnt vmcnt(0)" ::: "memory"); }
    __syncthreads();
    int cb = 0;
#pragma unroll 1
    for (int T = 0; T < ntile; ++T) {
        const bool more = T + 2 < ntile;
        if (more) { const int nb = cb == 0 ? 2 : cb - 1; ILOAD(T + 2, nb); }
        const LAS unsigned char* kb = lds + cb * 32768;
#pragma unroll
        for (int hf = 0; hf < 2; ++hf) {
        unsigned tk[4];
#define IDX_MMA(ACC, gi_) do { const LAS unsigned char* kr_ = kb + ((gi_) * 32 + r32) * 128; const int sw_ = (r32 >> 1) & 7; bf16x8 kf_[4]; \
            _Pragma("unroll") for (int s = 0; s < 4; ++s) kf_[s] = *(const LAS bf16x8*)(kr_ + (((2 * s + hi) ^ sw_) << 4)); \
            __builtin_amdgcn_s_setprio(1); ACC = f32x16{}; \
            _Pragma("unroll") for (int s = 0; s < 4; ++s) ACC = __builtin_amdgcn_mfma_f32_32x32x16_bf16(aq[s], kf_[s], ACC, 0, 0, 0); \
            __builtin_amdgcn_s_setprio(0); } while (0)
#define IDX_RELU(x) __int_as_float(max(__float_as_int(x), 0))
#define IDX_SCORE(ACC, g4_) do { float s0_ = 0.f, s1_ = 0.f; \
            _Pragma("unroll") for (int r = 0; r < 8; ++r) { s0_ = fmaf(wv[r], IDX_RELU(ACC[r]), s0_); s1_ = fmaf(wv[8 + r], IDX_RELU(ACC[8 + r]), s1_); } \
            auto rr_ = __builtin_amdgcn_permlane32_swap(__float_as_uint(s0_), __float_as_uint(s1_), false, false); \
            tk[g4_] = (T * 8 + 4 * hf + (g4_) < ng) ? ordkey(__uint_as_float(rr_[0]) + __uint_as_float(rr_[1])) : 0u; } while (0)
        f32x16 accA, accB;
        IDX_MMA(accA, 4 * hf + 0);
        IDX_MMA(accB, 4 * hf + 1); IDX_SCORE(accA, 0);
        IDX_MMA(accA, 4 * hf + 2); IDX_SCORE(accB, 1);
        IDX_MMA(accB, 4 * hf + 3); IDX_SCORE(accA, 2);
        IDX_SCORE(accB, 3);
#undef IDX_MMA
#undef IDX_RELU
#undef IDX_SCORE
        switch (T) {
#define KXCASE(n) case n: _Pragma("unroll") for (int i = 0; i < 4; ++i) kx[8 * n + 4 * hf + i] = tk[i]; break;
            KXCASE(0) KXCASE(1) KXCASE(2) KXCASE(3) KXCASE(4) KXCASE(5) KXCASE(6) KXCASE(7) KXCASE(8) KXCASE(9) KXCASE(10) KXCASE(11) KXCASE(12) KXCASE(13) KXCASE(14) KXCASE(15)
#undef KXCASE
            default: break;
        }
        }
        if (more) asm volatile("s_waitcnt vmcnt(4)" ::: "memory"); else asm volatile("s_waitcnt vmcnt(0)" ::: "memory");
        __syncthreads();
        cb = cb == 2 ? 0 : cb + 1;
    }
#undef ILOAD
    unsigned Tk = 0u;
    if (ng > 8) {
        unsigned kmax = 0u, kmn1 = 0xffffffffu;
#pragma unroll
        for (int gg = 0; gg < 16; ++gg) if (8 * gg < ng) {
#pragma unroll
            for (int k = 0; k < 8; ++k) { kmax = max(kmax, kx[8 * gg + k]); kmn1 = min(kmn1, kx[8 * gg + k] - 1u); } }
        kmax = xmax_u<32>(kmax); kmn1 = xmin_u<32>(kmn1);
        unsigned lo_k = kmn1 + 1u, hi_k = kmax + 1u;
        float dlo = (float)(32 * ng - 256) + 0.5f, dhi = 255.5f;
        int side = 0;
        bool done = false;
        if (hi_k - lo_k <= 1u) { Tk = lo_k; done = true; }
        for (int it = 0; it < 96; ++it) {
            const unsigned wd = hi_k - lo_k;
            const float frac = dlo * __builtin_amdgcn_rcpf(dlo + dhi);
            const float flo = __uint_as_float(keyinv(lo_k)), fhi = __uint_as_float(keyinv(min(hi_k, 0xff7fffffu)));
            unsigned Tt = wd < (1u << 23) ? lo_k + (unsigned)((float)wd * frac) : ordkey(flo + (fhi - flo) * frac);
            if (it >= 16) Tt = lo_k + (wd >> 1);
            Tt = min(max(Tt, lo_k + 1u), hi_k - 1u);
            if (done) Tt = Tk;
            int c4[4] = {0, 0, 0, 0};
#pragma unroll
            for (int gg = 0; gg < 16; ++gg) if (8 * gg < ng) {
#pragma unroll
                for (int k = 0; k < 8; ++k) c4[k & 3] += (kx[8 * gg + k] >= Tt) ? 1 : 0; }
            int cnt = (c4[0] + c4[1]) + (c4[2] + c4[3]);
            cnt = xsum_i<32>(cnt);
            if (!done) {
                if (cnt == 256) { Tk = Tt; done = true; }
                else if (cnt > 256) { lo_k = Tt; dlo = (float)(cnt - 256) + 0.5f; if (side == 1) dhi *= 0.5f; side = 1; }
                else { hi_k = Tt; dhi = (float)(256 - cnt) - 0.5f; if (side == 2) dlo *= 0.5f; side = 2; }
                if (!done && hi_k - lo_k <= 1u) { Tk = lo_k; done = true; }
            }
            if (__all(done)) break;
        }
    }
    unsigned wa0 = 0u, wa1 = 0u, wb0 = 0u, wb1 = 0u;
#pragma unroll
    for (int g = 0; g < 128; ++g) if (g < ng) {
        const unsigned long long bal = __ballot(kx[g] >= Tk);
        const unsigned lo = (unsigned)bal, hh = (unsigned)(bal >> 32);
        if (g < 64) { asm volatile("s_nop 1\n\tv_writelane_b32 %0, %1, %2" : "+v"(wa0) : "s"(lo), "n"(g & 63)); asm volatile("s_nop 1\n\tv_writelane_b32 %0, %1, %2" : "+v"(wa1) : "s"(hh), "n"(g & 63)); }
        else { asm volatile("s_nop 1\n\tv_writelane_b32 %0, %1, %2" : "+v"(wb0) : "s"(lo), "n"(g & 63)); asm volatile("s_nop 1\n\tv_writelane_b32 %0, %1, %2" : "+v"(wb1) : "s"(hh), "n"(g & 63)); }
    }
    unsigned* mr = MASK + (size_t)(m0 + 2 * wave) * 128;
    mr[lane] = wa0; mr[64 + lane] = wb0; mr[128 + lane] = wa1; mr[192 + lane] = wb1;
}

constexpr int NB_UNITS = NB * 8 * 16, NC_UNITS = NB * 4 * 16, NI_UNITS = NB * 256, P9_ITEMS = NB_UNITS + NC_UNITS, NA_UNITS = NB * 4 * 16;
__device__ __forceinline__ void attn_phase_all(Frame& F, KParams p, int qid, int l) {
    const float* gqa = p->in[I_GQA] + l * 128; const float* gqn = p->in[I_GQN] + l * 128; const float* gqr = p->in[I_GQR] + l * 64; const float* tab = (const float*)(p->ws + WS_TAB);
    const bf16* P = (const bf16*)(p->ws + WS_P); const bf16* QB = (const bf16*)(p->ws + WS_QB); const bf16* KVB = (const bf16*)(p->ws + WS_KVB); bf16* MIX = (bf16*)(p->ws + WS_H); const unsigned* MASK = (const unsigned*)(p->ws + WS_MASK);
    for (int it = q_next(F, qid); it < NB_UNITS + NC_UNITS + NA_UNITS; it = q_next(F, qid)) {
        const int lvl = it >> 7, r = it & 127, qb = 15 - lvl;
        if (r < 64) { const int b = r >> 3, h = r & 7; const size_t m0 = (size_t)b * SEQ + qb * 256, k0 = (size_t)b * SEQ;
            att::attn_unit<1>(QB + m0 * NQB + h * 192, NQB, KVB + k0 * NKVB + h * 256, KVB + k0 * NKVB + h * 256 + 128, NKVB, P + k0 * NP + PC_KR, MIX + m0 * DM + 512 + h * 128, DM, 4 * (qb + 1), qb * 256, nullptr, (char*)F.lds, F.wave, gqn, gqr, tab);
        } else if (r < 96) { const int bh = r - 64, b = bh >> 2, h = bh & 3; const size_t m0 = (size_t)b * SEQ + qb * 256, k0 = (size_t)b * SEQ;
            att::attn_unit<2>(P + m0 * NP + PC_QC + h * 128, NP, P + k0 * NP + PC_KC + h * 128, P + k0 * NP + PC_VC + h * 128, NP, nullptr, MIX + m0 * DM + 1536 + h * 128, DM, 4 * (qb + 1), qb * 256, nullptr, (char*)F.lds, F.wave);
        } else { const int bh = r - 96, b = bh >> 2, h = bh & 3; const size_t m0 = (size_t)b * SEQ + qb * 256, k0 = (size_t)b * SEQ;
            att::attn_unit<0>(P + m0 * NP + PC_QA + h * 128, NP, P + k0 * NP + PC_KA + h * 128, P + k0 * NP + PC_VA + h * 128, NP, nullptr, MIX + m0 * DM + h * 128, DM, 4 * (qb + 1), qb * 256, MASK + m0 * 128, (char*)F.lds, F.wave, gqa, nullptr, tab);
        }
    }
}
__device__ __forceinline__ void indexer_phase(Frame& F, KParams p, int qid) {
    for (int it = q_next(F, qid); it < NI_UNITS; it = q_next(F, qid)) { const int u16 = 255 - it / 8, b = it % 8; indexer_unit(p, b, u16, F.lds, F.tid); }
}

#ifndef FFN_SPLIT
#define FFN_SPLIT 1
#endif
constexpr int N_PHASES = 25 + 8 * (FFN_SPLIT - 1);
#ifndef WGM_RESID
#define WGM_RESID 4
#endif

__global__ void __launch_bounds__(NWAVES * 64, 2) mega_fwd(Params p_unused) {
    KParams p = (KParams)__builtin_amdgcn_kernarg_segment_ptr();
    extern __shared__ __attribute__((aligned(16))) unsigned char lds_raw[];
    Frame F;
    F.lds = (LAS unsigned char*)lds_raw; F.MISC = (volatile LAS unsigned*)(F.lds + MISC_OFF);
    F.tid = threadIdx.x; F.lane = F.tid & 63; F.wave = __builtin_amdgcn_readfirstlane(F.tid >> 6); F.wave0 = F.wave;
    F.G = gridDim.x; { const int bx = blockIdx.x; F.vcu = (F.G % 8 == 0) ? (bx % 8) * (F.G / 8) + bx / 8 : bx; }
    F.ctl = (gu32*)(p->ws + WS_CTL);
    for (int u = F.tid; u < (LDS_BYTES - LDSCTL_OFF) / 4; u += NWAVES * 64) ((LAS unsigned*)(F.lds + LDSCTL_OFF))[u] = 0u;
    __syncthreads();
    const int lo = p->ph_lo, hi = p->ph_hi;
    XcdBarrier bar; bar.bar = (unsigned*)(F.ctl + CW_BAR); bar.x = 0; bar.st = nullptr;
    if (hi - lo > 1) bar = xcd_barrier_post((unsigned*)(F.ctl + CW_BAR), F.MISC + 8);
    int ph = 0;
#define RUN (relaunder(F), ({ asm volatile("" : "+s"(p)); 0; }), lo <= ph && ph < hi)
#define SEAM do { if (lo <= ph && ph + 1 < hi) { relaunder(F); xcd_barrier(bar, F.tid == 0); } ++ph; } while (0)
#define WSP(T, off) ((T*)(p->ws + (off)))
    if (RUN) p0_prologue(F, p);
    SEAM;
    for (int hl = 0; hl < 2 * NLAYER; ++hl) {
        const int l = hl >> 1, f = hl & 1;
#define MODL ((const float*)(p->ws + WS_MOD) + (size_t)l * NB * NMOD)
#define WL(off) ((const bf16*)(p->ws + WS_W + (size_t)l * LW_BYTES + (off)))
        if (f) {
            if (RUN) norm_phase(F, p->out, p->in[I_GMIX] + l * DM, MODL, 3, 4, WSP(bf16, WS_H));
            SEAM;
            if (RUN) { pg8::Gemm g{WSP(bf16, WS_H), WL(LW_IN), M, NP, DM, DM, DM}; pg8::StaticOrder S; S.init(M, NP, F.G, (int)blockIdx.x); pg8::EpiBf16 E{WSP(bf16, WS_P), NP};
                pg8::gemm_phase<pg8::EpiBf16, pg8::StaticOrder, true, true>(F.lds, g, S, E, F.wave); }
            SEAM;
            if (RUN) { post1_phase(F, p, l); indexer_phase(F, p, 1 + 2 * l); }
            SEAM;
            if (RUN) {
                { pg8::Gemm g{WSP(bf16, WS_P) + PC_CQ, WL(LW_UQ), M, NQB, 512, NP, 512}; pg8::StaticOrder S; S.init(M, NQB, F.G, (int)blockIdx.x); pg8::EpiBf16 E{WSP(bf16, WS_QB), NQB};
                  pg8::gemm_phase<pg8::EpiBf16, pg8::StaticOrder, true, true>(F.lds, g, S, E, F.wave); }
                relaunder(F); asm volatile("" : "+s"(p));
                { pg8::Gemm g{WSP(bf16, WS_P) + PC_CKV, WL(LW_UKV), M, NKVB, 128, NP, 128}; pg8::StaticOrder S; S.init(M, NKVB, F.G, (int)blockIdx.x); pg8::EpiKV E{WSP(bf16, WS_KVB), p->in[I_GKN] + l * 128, (LAS float*)(F.lds + RING_BYTES + 4096), NKVB};
                  pg8::gemm_phase<pg8::EpiKV, pg8::StaticOrder, true, true>(F.lds, g, S, E, F.wave); }
            }
            SEAM;
            if (RUN) attn_phase_all(F, p, 2 + 2 * l, l);
            SEAM;
            if (RUN) { pg8::Gemm g{WSP(bf16, WS_H), WL(LW_OUT), M, DM, DM, DM, DM}; pg8::StaticOrder S; S.init(M, DM, F.G, (int)blockIdx.x, WGM_RESID); pg8::EpiResid E{p->out, p->out, MODL + 5 * DM, 1.0f};
                pg8::gemm_phase<pg8::EpiResid, pg8::StaticOrder, true, true>(F.lds, g, S, E, F.wave); }
            SEAM;
        }
#define XIN ((hl == 0) ? p->in[I_X] : (const float*)p->out)
        if (RUN) norm_phase(F, XIN, p->in[f ? I_GFFN2 : I_GFFN1] + l * DM, MODL, f ? 6 : 0, f ? 7 : 1, WSP(bf16, WS_H));
        SEAM;
        for (int mh = 0; mh < FFN_SPLIT; ++mh) {
            constexpr int MS = M / FFN_SPLIT; const size_t r0 = (size_t)mh * MS;
            if (RUN) { pg8::Gemm g{WSP(bf16, WS_H) + r0 * DM, WL(f ? LW_GU2 : LW_GU1), MS, 2 * FF, DM, DM, DM}; pg8::StaticOrder S; S.init(MS, 2 * FF, F.G, (int)blockIdx.x); pg8::EpiSwiGLU E{WSP(bf16, WS_HID), FF};
                pg8::gemm_phase<pg8::EpiSwiGLU, pg8::StaticOrder, true, true>(F.lds, g, S, E, F.wave); }
            SEAM;
            if (RUN) { pg8::Gemm g{WSP(bf16, WS_HID), WL(f ? LW_DN2 : LW_DN1), MS, DM, FF, FF, FF}; pg8::StaticOrder S; S.init(MS, DM, F.G, (int)blockIdx.x, WGM_RESID, 1);
                pg8::EpiResid E{XIN + r0 * DM, p->out + r0 * DM, MODL + (f ? 8 : 2) * DM + (r0 / SEQ) * NMOD, 0.5f};
                pg8::gemm_phase<pg8::EpiResid, pg8::StaticOrder, true, true>(F.lds, g, S, E, F.wave); }
            SEAM;
        }
    }
#undef RUN
#undef SEAM
}

extern "C" void kernel_launch(void* const* d_in, const int* in_sizes, int n_in, void* d_out, int out_size, void* d_ws, size_t ws_size, hipStream_t stream) {
    static int grid = 0;
    if (grid == 0) {
        if (n_in != 25 || in_sizes[0] != M * DM || out_size != M * DM || ws_size < WS_END) { fprintf(stderr, "kernel_launch: shape mismatch: n_in %d in0 %d out %d ws %zu (need %zu)\n", n_in, n_in > 0 ? in_sizes[0] : -1, out_size, ws_size, (size_t)WS_END); grid = -1; return; }
        int dev = 0, cus = 0, per_cu = 0;
        if (hipGetDevice(&dev) != hipSuccess || hipDeviceGetAttribute(&cus, hipDeviceAttributeMultiprocessorCount, dev) != hipSuccess) { grid = -1; return; }
        if (hipFuncSetAttribute((const void*)mega_fwd, hipFuncAttributeMaxDynamicSharedMemorySize, LDS_BYTES) != hipSuccess) { fprintf(stderr, "kernel_launch: hipFuncSetAttribute failed\n"); grid = -1; return; }
        if (hipOccupancyMaxActiveBlocksPerMultiprocessor(&per_cu, (const void*)mega_fwd, NWAVES * 64, LDS_BYTES) != hipSuccess || per_cu < 1) fprintf(stderr, "kernel_launch: occupancy query reports %d blocks per CU\n", per_cu);
        (void)hipGetLastError();
        grid = cus;
    }
    if (grid < 0) return;
    if (hipMemsetAsync((char*)d_ws + WS_CTL, 0, CTL_ZERO_BYTES, stream) != hipSuccess) return;
    Params a{};
    for (int i = 0; i < 25; ++i) a.in[i] = (const float*)d_in[i];
    a.out = (float*)d_out; a.ws = (unsigned char*)d_ws;
    const int nph = N_PHASES < PH_STOP ? N_PHASES : PH_STOP;
#if MK_N_LAUNCHES == 1
    a.ph_lo = 0; a.ph_hi = nph;
    hipLaunchKernelGGL(mega_fwd, dim3(grid), dim3(NWAVES * 64), LDS_BYTES, stream, a);
#else
    for (int k = 0; k < nph; ++k) { a.ph_lo = k; a.ph_hi = k + 1; hipLaunchKernelGGL(mega_fwd, dim3(grid), dim3(NWAVES * 64), LDS_BYTES, stream, a); }
#endif
    const hipError_t le = hipPeekAtLastError();
    if (le != hipSuccess) fprintf(stderr, "kernel_launch: launch failed: %s\n", hipGetErrorName(le));
}
```

```cpp
#include <hip/hip_runtime.h>
#include <cstdio>
#include <cstdint>

#ifndef MK_N_LAUNCHES
#define MK_N_LAUNCHES 1
#endif
#ifndef PH_STOP
#define PH_STOP 1000
#endif

#define GAS __attribute__((address_space(1)))
#define LAS __attribute__((address_space(3)))
typedef unsigned short bf16;
typedef unsigned v4u __attribute__((ext_vector_type(4)));
typedef unsigned v2u __attribute__((ext_vector_type(2)));
typedef float f32x4 __attribute__((ext_vector_type(4)));
typedef float f32x2 __attribute__((ext_vector_type(2)));
typedef float f32x16 __attribute__((ext_vector_type(16)));
typedef short bf16x8 __attribute__((ext_vector_type(8)));
typedef short s16x4 __attribute__((ext_vector_type(4)));
typedef GAS unsigned gu32;
#define RLX_AGENT __ATOMIC_RELAXED, __HIP_MEMORY_SCOPE_AGENT
#define LDS_WAIT() asm volatile("s_waitcnt lgkmcnt(0)" ::: "memory")
#define VM_WAIT() asm volatile("s_waitcnt vmcnt(0)" ::: "memory")
#define SBAR() __builtin_amdgcn_sched_barrier(0)
__device__ __forceinline__ unsigned cvt_pk_bf16(float lo, float hi) { unsigned r; asm volatile("v_cvt_pk_bf16_f32 %0, %1, %2" : "=v"(r) : "v"(lo), "v"(hi)); return r; }
__device__ __forceinline__ int lane_id_fresh() { int l; asm volatile("v_mbcnt_lo_u32_b32 %0, -1, 0\n\tv_mbcnt_hi_u32_b32 %0, -1, %0" : "=v"(l)); return l; }
__device__ __forceinline__ unsigned cvt_pk_bf16_nv(float lo, float hi) { unsigned r; asm("v_cvt_pk_bf16_f32 %0, %1, %2" : "=v"(r) : "v"(lo), "v"(hi)); return r; }
__device__ __forceinline__ float bf_lo(unsigned w) { return __uint_as_float(w << 16); }
__device__ __forceinline__ float bf_hi(unsigned w) { return __uint_as_float(w & 0xffff0000u); }

constexpr int NB = 8, SEQ = 4096, DM = 2048, M = NB * SEQ, FF = 5632, NLAYER = 2, NMOD = 9 * DM;
constexpr int NIN = 4816, NP = 5120;
constexpr int PC_QA = 0, PC_KA = 512, PC_VA = 1024, PC_QI = 1536, PC_KI = 2560, PC_WI = 2624, PC_CQ = 2688, PC_CKV = 3200, PC_KR = 3328, PC_QC = 3584, PC_KC = 4096, PC_VC = 4608;
constexpr int NQB = 1536, NKVB = 2048;
constexpr float NORM_EPS = 1e-6f;

namespace pg8 {
#define PG8_LAS __attribute__((address_space(3)))
typedef unsigned short bf16_t;
constexpr int BM = 256, BK = 64, HALF = 128, HTB = HALF * BK * 2  , STAGE_BYTES = 8 * HTB, NXCD = 8, WGM = 4;
__host__ __device__ __forceinline__ int lds_byte(int r, int c) { const int st = (r >> 4) * 2 + (c >> 5), rr = r & 15, cc = c & 31, ob = rr * 64 + cc * 2; return st * 1024 + (ob ^ (((ob >> 9) & 1) << 5)); }
__host__ __device__ __forceinline__ void stage_rc(int b, int& R, int& C) { const int st = b / 1024, sb = b % 1024, swz = sb ^ (((sb >> 9) & 1) << 5); R = (st >> 1) * 16 + swz / 64; C = (st & 1) * 32 + (swz % 64) / 2; }
__host__ __device__ __forceinline__ int perm32(int rho) { const int n = rho >> 4, i = rho & 15; return 8 * (i >> 2) + 4 * n + (i & 3); }
struct Unit { int pm, pn; };
struct Gemm { const bf16_t* A; const bf16_t* Bt; int M, N, K, lda, ldb; };
struct StaticOrder {
    int nM, nN, nwg, G, c, wgm, rev;
    __host__ __device__ void init(int M_, int N_, int G_, int c_, int wgm_ = WGM, int rev_ = 0) { nM = M_ / BM; nN = N_ / BM; nwg = nM * nN; G = G_; c = c_; wgm = wgm_; rev = rev_; }
    __host__ __device__ bool next(int i, Unit& u) const {
        const long L = (long)i * G + c; if (L >= nwg) return false;
        int wgid = (int)L; { const int q = nwg / NXCD, r = nwg % NXCD, xcd = wgid % NXCD, off = wgid / NXCD; wgid = (xcd < r ? xcd * (q + 1) : r * (q + 1) + (xcd - r) * q) + off; }
        const int nig = wgm * nN, gid = wgid / nig, fm = gid * wgm, gsz = (nM - fm) < wgm ? (nM - fm) : wgm;
        u.pm = fm + ((wgid % nig) % gsz); u.pn = (wgid % nig) / gsz; if (rev) u.pm = nM - 1 - u.pm; return true;
    }
};
struct EpiBf16 {
    static constexpr bool PERM = true;
    bf16_t* O; int ldc;
    __device__ __forceinline__ void operator()(const f32x4 (&acc)[2][2][4][2], const Unit& u, int wr, int wc, int fr, int fq) const {
        const int row0 = u.pm * BM + wr * 64 + fr, col0 = u.pn * BM + wc * 32 + 8 * fq;
#pragma unroll
        for (int ai = 0; ai < 2; ++ai)
#pragma unroll
            for (int m = 0; m < 4; ++m) { bf16_t* rowp = O + (size_t)(row0 + ai * HALF + m * 16) * ldc + col0;
#pragma unroll
                for (int bj = 0; bj < 2; ++bj) { const f32x4 v0 = acc[ai][bj][m][0], v1 = acc[ai][bj][m][1];
                    v4u w; w.x = cvt_pk_bf16(v0[0], v0[1]); w.y = cvt_pk_bf16(v0[2], v0[3]); w.z = cvt_pk_bf16(v1[0], v1[1]); w.w = cvt_pk_bf16(v1[2], v1[3]);
                    *(v4u*)(rowp + bj * HALF) = w; } }
    }
};
struct EpiKV {
    static constexpr bool PERM = true;
    bf16_t* O; const float* gk; PG8_LAS float* part; int ldc;
    __device__ __forceinline__ void operator()(const f32x4 (&acc)[2][2][4][2], const Unit& u, int wr, int wc, int fr, int fq) const {
        const int row0 = u.pm * BM + wr * 64 + fr, col0 = u.pn * BM + wc * 32 + 8 * fq;
#pragma unroll
        for (int ai = 0; ai < 2; ++ai)
#pragma unroll
            for (int m = 0; m < 4; ++m) { const f32x4 v0 = acc[ai][0][m][0], v1 = acc[ai][0][m][1];
                float s = ((v0[0] * v0[0] + v0[1] * v0[1]) + (v0[2] * v0[2] + v0[3] * v0[3])) + ((v1[0] * v1[0] + v1[1] * v1[1]) + (v1[2] * v1[2] + v1[3] * v1[3]));
                { auto r = __builtin_amdgcn_permlane16_swap(__float_as_uint(s), __float_as_uint(s), false, false); s = __uint_as_float(r[0]) + __uint_as_float(r[1]); }
                { auto r = __builtin_amdgcn_permlane32_swap(__float_as_uint(s), __float_as_uint(s), false, false); s = __uint_as_float(r[0]) + __uint_as_float(r[1]); }
                if (fq == 0) part[(wr * 128 + ai * 64 + m * 16 + fr) * 4 + wc] = s; }
        asm volatile("s_waitcnt lgkmcnt(0)" ::: "memory"); __builtin_amdgcn_s_barrier(); asm volatile("" ::: "memory");
        const f32x4 g0 = *(const f32x4*)(gk + wc * 32 + 8 * fq), g1 = *(const f32x4*)(gk + wc * 32 + 8 * fq + 4);
#pragma unroll
        for (int ai = 0; ai < 2; ++ai)
#pragma unroll
            for (int m = 0; m < 4; ++m) { bf16_t* rowp = O + (size_t)(row0 + ai * HALF + m * 16) * ldc + col0;
                const f32x4 q = *(const PG8_LAS f32x4*)(part + (wr * 128 + ai * 64 + m * 16 + fr) * 4);
                const float rstd = rsqrtf(((q[0] + q[1]) + (q[2] + q[3])) * (1.0f / 128) + NORM_EPS);
                const f32x4 v0 = acc[ai][0][m][0], v1 = acc[ai][0][m][1];
                v4u w; w.x = cvt_pk_bf16(v0[0] * rstd * g0[0], v0[1] * rstd * g0[1]); w.y = cvt_pk_bf16(v0[2] * rstd * g0[2], v0[3] * rstd * g0[3]);
                w.z = cvt_pk_bf16(v1[0] * rstd * g1[0], v1[1] * rstd * g1[1]); w.w = cvt_pk_bf16(v1[2] * rstd * g1[2], v1[3] * rstd * g1[3]);
                *(v4u*)rowp = w;
                const f32x4 x0 = acc[ai][1][m][0], x1 = acc[ai][1][m][1];
                v4u z; z.x = cvt_pk_bf16(x0[0], x0[1]); z.y = cvt_pk_bf16(x0[2], x0[3]); z.z = cvt_pk_bf16(x1[0], x1[1]); z.w = cvt_pk_bf16(x1[2], x1[3]);
                *(v4u*)(rowp + HALF) = z; }
    }
};
__device__ __forceinline__ void silu_mul4(const f32x4 g, const f32x4 u, unsigned& o0, unsigned& o1) {
    float t0, t1, t2, t3;
    asm volatile(
        "v_exp_f32_e32 %0, %4\n\tv_exp_f32_e32 %1, %5\n\tv_exp_f32_e32 %2, %6\n\tv_exp_f32_e32 %3, %7\n\t"
        "v_add_f32_e32 %0, 1.0, %0\n\tv_add_f32_e32 %1, 1.0, %1\n\tv_add_f32_e32 %2, 1.0, %2\n\tv_add_f32_e32 %3, 1.0, %3\n\t"
        "v_rcp_f32_e32 %0, %0\n\tv_rcp_f32_e32 %1, %1\n\tv_rcp_f32_e32 %2, %2\n\tv_rcp_f32_e32 %3, %3\n\t"
        "v_mul_f32_e32 %0, %4, %0\n\tv_mul_f32_e32 %1, %5, %1\n\tv_mul_f32_e32 %2, %6, %2\n\tv_mul_f32_e32 %3, %7, %3\n\t"
        "v_mul_f32_e32 %0, %8, %0\n\tv_mul_f32_e32 %1, %9, %1\n\tv_mul_f32_e32 %2, %10, %2\n\tv_mul_f32_e32 %3, %11, %3\n\t"
        "v_cvt_pk_bf16_f32 %0, %0, %1\n\tv_cvt_pk_bf16_f32 %2, %2, %3"
        : "=&v"(t0), "=&v"(t1), "=&v"(t2), "=&v"(t3)
        : "v"(g[0]), "v"(g[1]), "v"(g[2]), "v"(g[3]), "v"(u[0]), "v"(u[1]), "v"(u[2]), "v"(u[3]));
    o0 = __float_as_uint(t0); o1 = __float_as_uint(t2);
}
struct EpiSwiGLU {
    static constexpr bool PERM = true;
    bf16_t* O; int ldc;
    __device__ __forceinline__ void operator()(const f32x4 (&acc)[2][2][4][2], const Unit& u, int wr, int wc, int fr, int fq) const {
        const int row0 = u.pm * BM + wr * 64 + fr, col0 = u.pn * HALF + wc * 32 + 8 * fq;
#pragma unroll
        for (int ai = 0; ai < 2; ++ai)
#pragma unroll
            for (int m = 0; m < 4; ++m) { bf16_t* rowp = O + (size_t)(row0 + ai * HALF + m * 16) * ldc + col0;
                unsigned w0, w1, w2, w3; silu_mul4(acc[ai][0][m][0], acc[ai][1][m][0], w0, w1); silu_mul4(acc[ai][0][m][1], acc[ai][1][m][1], w2, w3);
                v4u w; w.x = w0; w.y = w1; w.z = w2; w.w = w3;
                *(v4u*)rowp = w; }
    }
};
struct EpiResid {
    static constexpr bool PERM = false;
    const float* base; float* out; const float* gate; float s;
    __device__ __forceinline__ void operator()(const f32x4 (&acc)[2][2][4][2], const Unit& u, int wr, int wc, int fr, int fq) const {
        const int row0 = u.pm * BM + wr * 64 + fr, col0 = u.pn * BM + wc * 32 + 4 * fq;
        const float* gp = gate + (size_t)((u.pm * BM) / SEQ) * NMOD + col0;
        f32x4 gv[2][2];
#pragma unroll
        for (int bj = 0; bj < 2; ++bj)
#pragma unroll
            for (int n = 0; n < 2; ++n) { const f32x4 g = *(const f32x4*)(gp + bj * HALF + n * 16); gv[bj][n] = (g + 1.0f) * s; }
#define ER_OFF(e) ((size_t)(row0 + ((e) >> 4) * HALF + (((e) >> 2) & 3) * 16) * DM + col0 + (((e) >> 1) & 1) * HALF + ((e) & 1) * 16)
        f32x4 bs[16];
#pragma unroll
        for (int e = 0; e < 16; ++e) bs[e] = *(const f32x4*)(base + ER_OFF(e));
#pragma unroll
        for (int e = 0; e < 32; ++e) {
            const f32x4 v = bs[e & 15] + gv[(e >> 1) & 1][e & 1] * acc[e >> 4][(e >> 1) & 1][(e >> 2) & 3][e & 1];
            *(f32x4*)(out + ER_OFF(e)) = v;
            if (e + 16 < 32) bs[e & 15] = *(const f32x4*)(base + ER_OFF(e + 16));
        }
#undef ER_OFF
    }
};
template <class Epi, class Sched, bool ALIGN_EPI = false, bool SP2 = false>
__device__ __forceinline__ void gemm_phase(PG8_LAS unsigned char* lds, const Gemm g, const Sched& S, const Epi& E, int wv) {
    int wid_ = wv; asm volatile("" : "+s"(wid_));
    const int wid = wid_, lane = lane_id_fresh(), tid = (wid << 6) | lane, wr = wid >> 2, wc = wid & 3, fr = lane & 15, fq = lane >> 4;
    int K = g.K; asm volatile("" : "+s"(K)); const int nt = K / BK;
    unsigned voffA[2], voffB[2];
#pragma unroll
    for (int i = 0; i < 2; ++i) { int R, C; stage_rc(tid * 16 + i * 8192, R, C); const int Rb = Epi::PERM ? ((R & ~31) + perm32(R & 31)) : R;
        voffA[i] = (unsigned)(R * g.lda + C) * 2u; voffB[i] = (unsigned)(Rb * g.ldb + C) * 2u; }
    const size_t kstep = (size_t)(BK * 2);
    const size_t hstepA = (size_t)HALF * g.lda * 2, hstepB = (size_t)HALF * g.ldb * 2;
    const size_t tstepA = 2 * hstepA, tstepB = 2 * hstepB;
    const unsigned ldsw = (unsigned)wid * 1024u;
    const int aoff = lds_byte(wr * 64 + fr, fq * 8), boff = lds_byte(wc * 32 + fr, fq * 8);
#define PG8_SA(b, h) (((b) * 2 + (h)) * HTB)
#define PG8_SB(b, h) ((4 + (b) * 2 + (h)) * HTB)
#define PG8_STAGE(bufoff, gbase, voff) do { const char* _gb = (const char*)(gbase); asm volatile("" : "+s"(_gb));   \
        _Pragma("unroll") for (int _i = 0; _i < 2; ++_i) __builtin_amdgcn_global_load_lds((const unsigned*)(_gb + (voff)[_i]), (PG8_LAS unsigned*)(lds + (bufoff) + ldsw + _i * 8192), 16, 0, 0); } while (0)
#define PG8_VOFF_FRESH asm volatile("" : "+v"(voffA[0]), "+v"(voffA[1]), "+v"(voffB[0]), "+v"(voffB[1]))
#define PG8_LDA(dst, b, h) do { _Pragma("unroll") for (int m = 0; m < 4; ++m) _Pragma("unroll") for (int k = 0; k < 2; ++k) dst[m][k] = *(const PG8_LAS bf16x8*)(lds + PG8_SA(b, h) + aoff + m * 2048 + k * 1024); } while (0)
#define PG8_LDB(dst, b, h) do { _Pragma("unroll") for (int n = 0; n < 2; ++n) _Pragma("unroll") for (int k = 0; k < 2; ++k) dst[n][k] = *(const PG8_LAS bf16x8*)(lds + PG8_SB(b, h) + boff + n * 2048 + k * 1024); } while (0)
#define PG8_MFMA(m, n, k, C) __builtin_amdgcn_mfma_f32_16x16x32_bf16(Bt_[n][k], At_[m][k], C, 0, 0, 0)
#define PG8_MMA(ai, bj, At, Bt, FIRST) do { auto& At_ = At; auto& Bt_ = Bt; __builtin_amdgcn_s_setprio(1); \
        if (FIRST) { _Pragma("unroll") for (int m = 0; m < 4; ++m) _Pragma("unroll") for (int n = 0; n < 2; ++n) acc[ai][bj][m][n] = PG8_MFMA(m, n, 0, ((f32x4){0.f, 0.f, 0.f, 0.f})); } \
        else       { _Pragma("unroll") for (int m = 0; m < 4; ++m) _Pragma("unroll") for (int n = 0; n < 2; ++n) acc[ai][bj][m][n] = PG8_MFMA(m, n, 0, acc[ai][bj][m][n]); } \
        _Pragma("unroll") for (int m = 0; m < 4; ++m) _Pragma("unroll") for (int n = 0; n < 2; ++n) acc[ai][bj][m][n] = PG8_MFMA(m, n, 1, acc[ai][bj][m][n]); \
        __builtin_amdgcn_s_setprio(0); } while (0)
#define PG8_WAIT_V(n) asm volatile("s_waitcnt vmcnt(" #n ")" ::: "memory")
#define PG8_WAIT_L(n) asm volatile("s_waitcnt lgkmcnt(" #n ")" ::: "memory")
#define PG8_BAR __builtin_amdgcn_s_barrier()
#define PG8_SCHED __builtin_amdgcn_sched_barrier(0)
    Unit cur, nxt; int ui = 0;
    if (!S.next(0, cur)) return;
    static_assert(SP2, "only the two-super-phase K-loop is kept");
    f32x4 acc[2][2][4][2];
    bf16x8 At[4][2], B0[2][2], B1[2][2];
    const char* cA = (const char*)g.A + (size_t)cur.pm * tstepA; const char* cB = (const char*)g.Bt + (size_t)cur.pn * tstepB;
    PG8_VOFF_FRESH;
    if constexpr (SP2) {
        PG8_STAGE(PG8_SB(0, 0), cB, voffB); PG8_STAGE(PG8_SB(0, 1), cB + hstepB, voffB); PG8_STAGE(PG8_SA(0, 0), cA, voffA); PG8_STAGE(PG8_SA(0, 1), cA + hstepA, voffA);
        if (wr == 1) PG8_BAR;
        PG8_WAIT_V(2); PG8_BAR;
        PG8_STAGE(PG8_SB(1, 0), cB + kstep, voffB); PG8_STAGE(PG8_SA(1, 0), cA + kstep, voffA); PG8_STAGE(PG8_SB(1, 1), cB + hstepB + kstep, voffB);
        PG8_WAIT_V(6); PG8_BAR;
    } else {
        PG8_STAGE(PG8_SB(0, 0), cB, voffB); PG8_STAGE(PG8_SA(0, 0), cA, voffA); PG8_STAGE(PG8_SB(0, 1), cB + hstepB, voffB); PG8_STAGE(PG8_SA(0, 1), cA + hstepA, voffA);
        if (wr == 1) PG8_BAR;
        PG8_WAIT_V(4); PG8_BAR;
        PG8_STAGE(PG8_SB(1, 0), cB + kstep, voffB); PG8_STAGE(PG8_SA(1, 0), cA + kstep, voffA); PG8_STAGE(PG8_SB(1, 1), cB + hstepB + kstep, voffB);
        PG8_WAIT_V(6); PG8_BAR;
    }
    for (;;) {
        const bool has_next = S.next(ui + 1, nxt);
        const char* nA = has_next ? (const char*)g.A + (size_t)nxt.pm * tstepA : cA; const char* nB = has_next ? (const char*)g.Bt + (size_t)nxt.pn * tstepB : cB;
#define PG8_KT2(t, FIRST) do { \
            const bool last = ((t) == nt - 2); \
            const char* a1 = cA + (size_t)((t) + 1) * kstep; \
            const char* a2 = last ? nA : cA + (size_t)((t) + 2) * kstep; const char* b2 = last ? nB : cB + (size_t)((t) + 2) * kstep; \
            const char* a3 = a2 + kstep; const char* b3 = b2 + kstep; PG8_VOFF_FRESH; \
            PG8_LDB(B0, 0, 0); PG8_LDB(B1, 0, 1); PG8_SCHED; PG8_LDA(At, 0, 0); PG8_STAGE(PG8_SA(1, 1), a1 + hstepA, voffA); \
            PG8_WAIT_V(8); PG8_WAIT_L(0); PG8_BAR; PG8_MMA(0, 0, At, B0, FIRST); PG8_MMA(0, 1, At, B1, FIRST); PG8_BAR; PG8_SCHED; \
            PG8_LDA(At, 0, 1); PG8_STAGE(PG8_SB(0, 0), b2, voffB); PG8_STAGE(PG8_SB(0, 1), b2 + hstepB, voffB); PG8_STAGE(PG8_SA(0, 0), a2, voffA); \
            PG8_WAIT_V(8); PG8_WAIT_L(0); PG8_BAR; PG8_MMA(1, 0, At, B0, FIRST); PG8_MMA(1, 1, At, B1, FIRST); PG8_BAR; PG8_SCHED; \
            PG8_LDB(B0, 1, 0); PG8_LDB(B1, 1, 1); PG8_SCHED; PG8_LDA(At, 1, 0); PG8_STAGE(PG8_SA(0, 1), a2 + hstepA, voffA); \
            PG8_WAIT_V(8); PG8_WAIT_L(0); PG8_BAR; PG8_MMA(0, 0, At, B0, false); PG8_MMA(0, 1, At, B1, false); PG8_BAR; PG8_SCHED; \
            PG8_LDA(At, 1, 1); PG8_STAGE(PG8_SB(1, 0), b3, voffB); PG8_STAGE(PG8_SB(1, 1), b3 + hstepB, voffB); PG8_STAGE(PG8_SA(1, 0), a3, voffA); \
            PG8_WAIT_V(8); PG8_WAIT_L(0); PG8_BAR; PG8_MMA(1, 0, At, B0, false); PG8_MMA(1, 1, At, B1, false); PG8_BAR; PG8_SCHED; \
        } while (0)
        for (int t = 0; t < nt; t += 2) { const bool first = (t == 0); PG8_KT2(t, first); }
#undef PG8_KT2
        if constexpr (ALIGN_EPI) { if (wr == 0) PG8_BAR; }
        { const int le = lane_id_fresh(); E(acc, cur, wr, wc, le & 15, le >> 4); }
        if (!has_next) break;
        cur = nxt; cA = nA; cB = nB; ++ui;
        if constexpr (ALIGN_EPI) { if (wr == 1) PG8_BAR; }
    }
    PG8_WAIT_V(0);
    if constexpr (!ALIGN_EPI) { if (wr == 0) PG8_BAR; }
    PG8_BAR;
#undef PG8_SA
#undef PG8_SB
#undef PG8_STAGE
#undef PG8_VOFF_FRESH
#undef PG8_LDA
#undef PG8_LDB
#undef PG8_MMA
#undef PG8_WAIT_V
#undef PG8_WAIT_L
#undef PG8_BAR
#undef PG8_SCHED
}
}

constexpr size_t MiB = 1u << 20;
constexpr size_t WS_CTL = 0, CTL_ZERO_BYTES = 1 * MiB;
constexpr size_t WS_MOD = 1 * MiB;
constexpr size_t WS_TAB = 3 * MiB;
constexpr size_t WS_W = 5 * MiB;
constexpr size_t W_GU = (size_t)2 * FF * DM * 2, W_DN = (size_t)DM * FF * 2, W_IN = (size_t)NP * DM * 2, W_UQ = (size_t)NQB * 512 * 2, W_UKV = (size_t)NKVB * 128 * 2, W_OUT = (size_t)DM * DM * 2;
constexpr size_t LW_GU1 = 0, LW_DN1 = LW_GU1 + W_GU, LW_GU2 = LW_DN1 + W_DN, LW_DN2 = LW_GU2 + W_GU, LW_IN = LW_DN2 + W_DN, LW_UQ = LW_IN + W_IN, LW_UKV = LW_UQ + W_UQ, LW_OUT = LW_UKV + W_UKV, LW_BYTES = LW_OUT + W_OUT;
constexpr size_t WS_H = WS_W + NLAYER * LW_BYTES;
constexpr size_t WS_SCR = WS_H + (size_t)M * DM * 2;
constexpr size_t WS_HID = WS_SCR;
constexpr size_t WS_P = WS_SCR, WS_QB = WS_P + (size_t)M * NP * 2, WS_KVB = WS_QB + (size_t)M * NQB * 2, WS_MASK = WS_KVB + (size_t)M * NKVB * 2, WS_KI = WS_MASK + (size_t)M * 128 * 4, WS_MIXEND = WS_KI + (size_t)M * 64 * 2;
constexpr size_t WS_END = (WS_MIXEND > WS_HID + (size_t)M * FF * 2) ? WS_MIXEND : WS_HID + (size_t)M * FF * 2;
static_assert(LW_BYTES % 256 == 0 && WS_H % 256 == 0 && WS_SCR % 256 == 0, "alignment");
constexpr int CW_BAR = 4096;
constexpr int CW_QUEUE = 16384;

constexpr int RING_BYTES = 131072;
constexpr int LDSCTL_OFF = RING_BYTES, MISC_OFF = LDSCTL_OFF + 320;
constexpr int LDS_BYTES = 147456;
constexpr int NWAVES = 8;

#define XB_TMO      128
#define XB_XCNT(j)  (256  + 64 * (j))
#define XB_XSUB(j)  (1280 + 64 * (j))
#define XB_XGEN(j)  (2304 + 64 * (j))
#define XB_TOP      3328
#define XB_TOPGEN   3392
#define XCD_BAR_WORDS 3456
#define XB_SPIN_CAP (1u << 18)

__device__ __forceinline__ unsigned xb_ld(unsigned* p)              { return __hip_atomic_load(p, __ATOMIC_RELAXED, __HIP_MEMORY_SCOPE_AGENT); }
__device__ __forceinline__ unsigned xb_add(unsigned* p, unsigned v) { return __hip_atomic_fetch_add(p, v, __ATOMIC_RELAXED, __HIP_MEMORY_SCOPE_AGENT); }
__device__ __forceinline__ unsigned xb_xcc_id() { return (unsigned)__builtin_amdgcn_s_getreg((3 << 11) | 20) & 0xFu; }
#define XB_SPIN(cond, bar) do { unsigned _sp = 0; while (cond) { __builtin_amdgcn_s_sleep(1); \
    if ((++_sp & 255u) == 0u) { if (xb_ld(&(bar)[XB_TMO])) break; if (_sp > XB_SPIN_CAP) { atomicAdd(&(bar)[XB_TMO], 1u); break; } } } } while (0)

struct XcdBarrier {
    unsigned* bar; unsigned x;
    volatile LAS unsigned* st;
};

__device__ __forceinline__ XcdBarrier xcd_barrier_post(unsigned* bar, volatile LAS unsigned* st) {
    XcdBarrier b; b.bar = bar; b.x = xb_xcc_id(); b.st = st;
    if (threadIdx.x == 0) (void)xb_add(&bar[XB_XCNT(b.x)], 1u);
    return b;
}
__device__ __forceinline__ void xcd_barrier_complete(unsigned* bar, unsigned x, unsigned& nloc, unsigned& nx) {
    const unsigned G = gridDim.x * gridDim.y * gridDim.z;
    unsigned sum, cnt, mine, sp = 0u;
    for (;;) {
        sum = 0u; cnt = 0u; mine = 0u;
#pragma unroll
        for (unsigned j = 0; j < 16; ++j) { const unsigned c = xb_ld(&bar[XB_XCNT(j)]); sum += c; cnt += (c > 0u) ? 1u : 0u; mine = (j == x) ? c : mine; }
        if (sum == G) break;
        __builtin_amdgcn_s_sleep(1);
        if ((++sp & 255u) == 0u) { if (xb_ld(&bar[XB_TMO])) break; if (sp > XB_SPIN_CAP) { atomicAdd(&bar[XB_TMO], 1u); break; } }
    }
    nloc = mine > 0u ? mine : 1u; nx = cnt > 0u ? cnt : 1u;
}

__device__ __forceinline__ void xcd_barrier(const XcdBarrier& b, const bool t0) {
    asm volatile("s_waitcnt vmcnt(0)" ::: "memory");
    __syncthreads();
    if (t0) {
        unsigned* bar = b.bar;
        __builtin_amdgcn_s_waitcnt(0);
        unsigned nloc = b.st[0], nx = b.st[1];
        if (nloc == 0u) { xcd_barrier_complete(bar, b.x, nloc, nx); b.st[0] = nloc; b.st[1] = nx; }
        const unsigned old = xb_add(&bar[XB_XSUB(b.x)], 1u);
        const unsigned gen = old / nloc;
        if (old + 1u == (gen + 1u) * nloc) {
            __builtin_amdgcn_fence(__ATOMIC_RELEASE, "agent");
            asm volatile("s_waitcnt vmcnt(0)" ::: "memory");
            const unsigned og = xb_add(&bar[XB_TOP], 1u);
            const unsigned tg = og / nx;
            if (og + 1u == (tg + 1u) * nx) xb_add(&bar[XB_TOPGEN], 1u);
            else XB_SPIN(xb_ld(&bar[XB_TOPGEN]) == tg, bar);
            __builtin_amdgcn_fence(__ATOMIC_ACQUIRE, "agent");
            xb_add(&bar[XB_XGEN(b.x)], 1u);
            asm volatile("s_waitcnt vmcnt(0)" ::: "memory");
        } else {
            XB_SPIN(xb_ld(&bar[XB_XGEN(b.x)]) == gen, bar);
            __builtin_amdgcn_fence(__ATOMIC_ACQUIRE, "agent");
            asm volatile("s_waitcnt vmcnt(0)" ::: "memory");
        }
    }
    __syncthreads();
}

struct Params { const float* in[25]; float* out; unsigned char* ws; int ph_lo, ph_hi; };
typedef const __attribute__((address_space(4))) Params* KParams;
enum { I_X = 0, I_C, I_WADA, I_BADA, I_GFFN1, I_W1G, I_W1U, I_W1D, I_GMIX, I_WIN, I_GQA, I_GKA, I_GCQ, I_GCKV, I_WUQ, I_WUKV, I_GQN, I_GKN, I_GQR, I_GKR, I_WOUT, I_GFFN2, I_W2G, I_W2U, I_W2D };
struct Frame {
    LAS unsigned char* lds; volatile LAS unsigned* MISC; gu32* ctl;
    int tid, lane, wave, vcu, G, wave0;
};
__device__ __forceinline__ void relaunder(Frame& F) { int w = F.wave0; asm volatile("" : "+s"(w)); const int l = lane_id_fresh(); F.wave = w; F.lane = l; F.tid = (w << 6) | l; }
#define XS_DPP(x, ctrl) __builtin_amdgcn_update_dpp(0, (x), (ctrl), 0xF, 0xF, true)
template <int W> __device__ __forceinline__ float xsum(float v) {
    if constexpr (W > 1) v += __int_as_float(XS_DPP(__float_as_int(v), 0xB1));
    if constexpr (W > 2) v += __int_as_float(XS_DPP(__float_as_int(v), 0x4E));
    if constexpr (W > 4) v += __int_as_float(XS_DPP(__float_as_int(v), 0x141));
    if constexpr (W > 8) v += __int_as_float(XS_DPP(__float_as_int(v), 0x140));
    if constexpr (W > 16) { auto r = __builtin_amdgcn_permlane16_swap(__float_as_uint(v), __float_as_uint(v), false, false); v = __uint_as_float(r[0]) + __uint_as_float(r[1]); }
    if constexpr (W > 32) { auto r = __builtin_amdgcn_permlane32_swap(__float_as_uint(v), __float_as_uint(v), false, false); v = __uint_as_float(r[0]) + __uint_as_float(r[1]); }
    return v;
}
template <int W> __device__ __forceinline__ int xsum_i(int v) {
    if constexpr (W > 1) v += XS_DPP(v, 0xB1);
    if constexpr (W > 2) v += XS_DPP(v, 0x4E);
    if constexpr (W > 4) v += XS_DPP(v, 0x141);
    if constexpr (W > 8) v += XS_DPP(v, 0x140);
    if constexpr (W > 16) { auto r = __builtin_amdgcn_permlane16_swap((unsigned)v, (unsigned)v, false, false); v = (int)(r[0] + r[1]); }
    if constexpr (W > 32) { auto r = __builtin_amdgcn_permlane32_swap((unsigned)v, (unsigned)v, false, false); v = (int)(r[0] + r[1]); }
    return v;
}
template <int W> __device__ __forceinline__ unsigned xmax_u(unsigned v) {
    if constexpr (W > 1) v = max(v, (unsigned)XS_DPP((int)v, 0xB1));
    if constexpr (W > 2) v = max(v, (unsigned)XS_DPP((int)v, 0x4E));
    if constexpr (W > 4) v = max(v, (unsigned)XS_DPP((int)v, 0x141));
    if constexpr (W > 8) v = max(v, (unsigned)XS_DPP((int)v, 0x140));
    if constexpr (W > 16) { auto r = __builtin_amdgcn_permlane16_swap(v, v, false, false); v = max(r[0], r[1]); }
    if constexpr (W > 32) { auto r = __builtin_amdgcn_permlane32_swap(v, v, false, false); v = max(r[0], r[1]); }
    return v;
}
template <int W> __device__ __forceinline__ unsigned xmin_u(unsigned v) { return ~xmax_u<W>(~v); }
__device__ __forceinline__ float wave_sum(float v) { return xsum<64>(v); }
__device__ __forceinline__ int q_next(Frame& F, int q) {
    __syncthreads();
    if (F.tid == 0) F.MISC[0] = __hip_atomic_fetch_add(F.ctl + CW_QUEUE + 64 * q, 1u, RLX_AGENT);
    __syncthreads();
    return (int)F.MISC[0];
}

struct XD { const float* src; bf16* dst; int ldsrc, lddst, width; float wsc; };
__device__ __forceinline__ void xpose_load(const XD& d, int lane, float (&v)[32]) {
    const int c = lane & 31, h = lane >> 5, cc = min(c, max(d.width - 1, 0));
    const unsigned lo = (unsigned)(h * d.ldsrc + cc) * 4u;
#pragma unroll
    for (int i = 0; i < 32; ++i) { const char* rb = (const char*)d.src + (size_t)(2 * i) * d.ldsrc * 4; v[i] = *(const float*)(rb + lo); }
}
__device__ __forceinline__ void xpose_emit(const XD& d, int lane, const float (&v)[32], LAS float* scr) {
    const int c = lane & 31, h = lane >> 5; const bool ok = c < d.width;
#pragma unroll
    for (int i = 0; i < 32; ++i) scr[(2 * i + h) * 33 + c] = ok ? v[i] * d.wsc : 0.f;
    LDS_WAIT(); asm volatile("" ::: "memory");
    const int c8 = lane & 7;
#pragma unroll
    for (int j = 0; j < 4; ++j) { const int n = (lane >> 3) + 8 * j; const LAS float* s = scr + (8 * c8) * 33 + n;
        v4u o; o.x = cvt_pk_bf16_nv(s[0 * 33], s[1 * 33]); o.y = cvt_pk_bf16_nv(s[2 * 33], s[3 * 33]); o.z = cvt_pk_bf16_nv(s[4 * 33], s[5 * 33]); o.w = cvt_pk_bf16_nv(s[6 * 33], s[7 * 33]);
        if (n < d.width) *(v4u*)(d.dst + (size_t)n * d.lddst + 8 * c8) = o; }
    LDS_WAIT(); asm volatile("" ::: "memory");
}
constexpr int XB_FF = 5632, XB_WIN = 32 * 151, XB_UQ = 7 * 48, XB_UKV = 2 * 64, XB_OUT = 32 * 64;
constexpr int XB_LAYER = 6 * XB_FF + XB_WIN + XB_UQ + XB_UKV + XB_OUT, XB_TOTAL = NLAYER * XB_LAYER;
constexpr int XPW = 2, XCHUNKS = (XB_TOTAL + 8 * XPW - 1) / (8 * XPW);
constexpr int ADA_ITEMS = NLAYER * 72, P0_ITEMS = ADA_ITEMS + XCHUNKS;
#define XD_SET(W_, ldsrc_, k0_, csrc_, width_, WT_, lddst_, drow_) do { d.src = (W_) + (size_t)(k0_) * (ldsrc_) + (csrc_); d.ldsrc = (ldsrc_); d.width = (width_); d.dst = (WT_) + (size_t)(drow_) * (lddst_) + (k0_); d.lddst = (lddst_); } while (0)
__device__ __forceinline__ XD xpose_desc(KParams p, int blk) {
    XD d; d.src = p->in[I_WOUT]; d.dst = (bf16*)(p->ws + WS_W); d.ldsrc = 0; d.lddst = 0; d.width = 0; d.wsc = 1.0f;
    if (blk >= XB_TOTAL) return d;
    const int l = blk / XB_LAYER; int r = blk % XB_LAYER;
    unsigned char* wl = p->ws + WS_W + (size_t)l * LW_BYTES;
    if (r < 6 * XB_FF) {
        const int j = r / XB_FF, b = r % XB_FF, f2 = j / 3, jj = j % 3;
        if (jj < 2) { const int kb = b / 176, nb = b % 176, n = 32 * nb;
            const float* W = p->in[(f2 ? I_W2G : I_W1G) + jj] + (size_t)l * DM * FF;
            XD_SET(W, FF, 64 * kb, n, 32, (bf16*)(wl + (f2 ? LW_GU2 : LW_GU1)), DM, (n >> 7) * 256 + (n & 127) + 128 * jj); d.wsc = jj == 0 ? -1.4426950408889634f : -0.6931471805599453f;
        } else { const int kb = b / 64, nb = b % 64;
            const float* W = p->in[f2 ? I_W2D : I_W1D] + (size_t)l * FF * DM;
            XD_SET(W, DM, 64 * kb, 32 * nb, 32, (bf16*)(wl + (f2 ? LW_DN2 : LW_DN1)), FF, 32 * nb); }
        return d; }
    r -= 6 * XB_FF;
    if (r < XB_WIN) { const int kb = r / 151, nb = r % 151;
        int s0, d0, w = 32, nb0;
        if (nb < 16) { s0 = 0; d0 = PC_QA; nb0 = 0; } else if (nb < 32) { s0 = 512; d0 = PC_KA; nb0 = 16; } else if (nb < 48) { s0 = 1024; d0 = PC_VA; nb0 = 32; }
        else if (nb < 80) { s0 = 1536; d0 = PC_QI; nb0 = 48; } else if (nb < 82) { s0 = 2560; d0 = PC_KI; nb0 = 80; } else if (nb < 83) { s0 = 2624; d0 = PC_WI; nb0 = 82; w = 16; }
        else if (nb < 97) { s0 = 2640; d0 = PC_CQ; nb0 = 83; } else if (nb < 101) { s0 = 3088; d0 = PC_CKV; nb0 = 97; } else if (nb < 103) { s0 = 3216; d0 = PC_KR; nb0 = 101; }
        else if (nb < 119) { s0 = 3280; d0 = PC_QC; nb0 = 103; } else if (nb < 135) { s0 = 3792; d0 = PC_KC; nb0 = 119; } else { s0 = 4304; d0 = PC_VC; nb0 = 135; }
        const int o = 32 * (nb - nb0);
        XD_SET(p->in[I_WIN] + (size_t)l * DM * NIN, NIN, 64 * kb, s0 + o, w, (bf16*)(wl + LW_IN), DM, d0 + o); return d; }
    r -= XB_WIN;
    if (r < XB_UQ) { const int kb = r / 48, nb = r % 48; XD_SET(p->in[I_WUQ] + (size_t)l * 448 * NQB, NQB, 64 * kb, 32 * nb, 32, (bf16*)(wl + LW_UQ), 512, 32 * nb); return d; }
    r -= XB_UQ;
    if (r < XB_UKV) { const int kb = r / 64, nb = r % 64; XD_SET(p->in[I_WUKV] + (size_t)l * 128 * NKVB, NKVB, 64 * kb, 32 * nb, 32, (bf16*)(wl + LW_UKV), 128, 32 * nb); return d; }
    r -= XB_UKV;
    { const int kb = r / 64, nb = r % 64; XD_SET(p->in[I_WOUT] + (size_t)l * DM * DM, DM, 64 * kb, 32 * nb, 32, (bf16*)(wl + LW_OUT), DM, 32 * nb); }
    return d;
}
#undef XD_SET
__device__ __forceinline__ void ada_item(Frame& F, KParams p, int it) {
    const int l = it / 72, cg = it % 72;
    LAS float* cact = (LAS float*)F.lds;
    LAS float* red = (LAS float*)(F.lds + 65536);
    for (int idx = F.tid; idx < NB * DM; idx += 512) { const int b = idx & 7, k = idx >> 3; const float c = p->in[I_C][b * DM + k]; cact[idx] = c * __builtin_amdgcn_rcpf(1.0f + __expf(-c)); }
    __syncthreads();
    const float* W = p->in[I_WADA] + (size_t)l * DM * NMOD + cg * 256 + 4 * F.lane;
    f32x4 acc[8];
#pragma unroll
    for (int b = 0; b < 8; ++b) acc[b] = (f32x4){0.f, 0.f, 0.f, 0.f};
#pragma unroll 8
    for (int k = F.wave; k < DM; k += 8) {
        const f32x4 w = *(const f32x4*)(W + (size_t)k * NMOD);
        const f32x4 c0 = *(const LAS f32x4*)(cact + k * 8), c1 = *(const LAS f32x4*)(cact + k * 8 + 4);
        acc[0] += w * c0[0]; acc[1] += w * c0[1]; acc[2] += w * c0[2]; acc[3] += w * c0[3];
        acc[4] += w * c1[0]; acc[5] += w * c1[1]; acc[6] += w * c1[2]; acc[7] += w * c1[3];
    }
#pragma unroll
    for (int b = 0; b < 8; ++b) *(LAS f32x4*)(red + (F.wave * 8 + b) * 256 + 4 * F.lane) = acc[b];
    __syncthreads();
    { const int b = F.tid >> 6; f32x4 s = (f32x4){0.f, 0.f, 0.f, 0.f};
#pragma unroll
      for (int w = 0; w < 8; ++w) s += *(const LAS f32x4*)(red + (w * 8 + b) * 256 + 4 * F.lane);
      const int col = cg * 256 + 4 * F.lane;
      s += *(const f32x4*)(p->in[I_BADA] + (size_t)l * NMOD + col);
      *(f32x4*)((float*)(p->ws + WS_MOD) + (size_t)(l * NB + b) * NMOD + col) = s; }
}
__device__ __forceinline__ void p0_prologue(Frame& F, KParams p) {
    const int gt = F.vcu * 512 + F.tid, NGT = F.G * 512;
    for (int l = 0; l < NLAYER; ++l) {
        bf16* win = (bf16*)(p->ws + WS_W + (size_t)l * LW_BYTES + LW_IN); bf16* wuq = (bf16*)(p->ws + WS_W + (size_t)l * LW_BYTES + LW_UQ);
        for (int e = gt; e < 304 * (DM / 8); e += NGT) { int r = e / (DM / 8); const int c = e % (DM / 8);
            r = r < 48 ? 2640 + r : (r < 112 ? 3136 + (r - 48) : 3392 + (r - 112));
            *(v4u*)(win + (size_t)r * DM + 8 * c) = (v4u){0u, 0u, 0u, 0u}; }
        for (int e = gt; e < NQB * 8; e += NGT) *(v4u*)(wuq + (size_t)(e >> 3) * 512 + 448 + 8 * (e & 7)) = (v4u){0u, 0u, 0u, 0u};
    }
    { float* tab = (float*)(p->ws + WS_TAB);
      for (int e = gt; e < SEQ * 48; e += NGT) { const int t = e / 48, j = e % 48; const bool part = j < 16; const int i = part ? j : j - 16;
          const double r = part ? 0.44036660267178046 : 0.6636012376960885; double inv = 1.0; for (int q = 0; q < i; ++q) inv *= r;
          const float ang = (float)t * (float)inv; const double rev = (double)ang * 0.15915494309189535; const float fr = (float)(rev - floor(rev));
          const float cs = __builtin_amdgcn_cosf(fr), sn = __builtin_amdgcn_sinf(fr);
          if (part) { tab[t * 96 + i] = cs; tab[t * 96 + 16 + i] = sn; } else { tab[t * 96 + 32 + i] = cs; tab[t * 96 + 64 + i] = sn; } } }
    LAS float* scr = (LAS float*)(F.lds + F.wave * 16384);
    int it = q_next(F, 0);
    for (; it < ADA_ITEMS; it = q_next(F, 0)) ada_item(F, p, it);
#define XBLK(item, j) ((((item) - ADA_ITEMS) * 8 + F.wave) * XPW + (j))
    if (it < P0_ITEMS) {
        float va0[32], va1[32], vb0[32], vb1[32];
        XD a0 = xpose_desc(p, XBLK(it, 0)), a1 = xpose_desc(p, XBLK(it, 1)), b0, b1;
        xpose_load(a0, F.lane, va0); xpose_load(a1, F.lane, va1);
        for (;;) {
            int nx = q_next(F, 0);
            b0 = xpose_desc(p, XBLK(nx, 0)); b1 = xpose_desc(p, XBLK(nx, 1)); xpose_load(b0, F.lane, vb0); xpose_load(b1, F.lane, vb1);
            xpose_emit(a0, F.lane, va0, scr); xpose_emit(a1, F.lane, va1, scr);
            if (nx >= P0_ITEMS) break;
            nx = q_next(F, 0);
            a0 = xpose_desc(p, XBLK(nx, 0)); a1 = xpose_desc(p, XBLK(nx, 1)); xpose_load(a0, F.lane, va0); xpose_load(a1, F.lane, va1);
            xpose_emit(b0, F.lane, vb0, scr); xpose_emit(b1, F.lane, vb1, scr);
            if (nx >= P0_ITEMS) break;
        }
    }
#undef XBLK
}

__device__ __forceinline__ void norm_phase(Frame& F, const float* x, const float* g, const float* modl, int ch_shift, int ch_scale, bf16* H) {
    const int gw = F.vcu * NWAVES + F.wave, NGW = F.G * NWAVES;
    for (int m0 = gw * 16; m0 < M; m0 += NGW * 16) {
        const int b = m0 >> 12;
        const float* sh = modl + (size_t)b * NMOD + ch_shift * DM + 4 * F.lane; const float* sc = modl + (size_t)b * NMOD + ch_scale * DM + 4 * F.lane; const float* gg = g + 4 * F.lane;
        f32x4 av[8], tv[8];
#pragma unroll
        for (int j = 0; j < 8; ++j) { av[j] = *(const f32x4*)(gg + 256 * j) * (*(const f32x4*)(sc + 256 * j) + 1.0f); tv[j] = *(const f32x4*)(sh + 256 * j); }
        const float* xr = x + (size_t)m0 * DM + 4 * F.lane;
        f32x4 v[8], vn[8];
#pragma unroll
        for (int j = 0; j < 8; ++j) v[j] = *(const f32x4*)(xr + 256 * j);
#pragma unroll 1
        for (int r = 0; r < 16; ++r) {
            if (r + 1 < 16) {
#pragma unroll
                for (int j = 0; j < 8; ++j) vn[j] = *(const f32x4*)(xr + (size_t)(r + 1) * DM + 256 * j); }
            float ss = 0.f;
#pragma unroll
            for (int j = 0; j < 8; ++j) ss += (v[j][0] * v[j][0] + v[j][1] * v[j][1]) + (v[j][2] * v[j][2] + v[j][3] * v[j][3]);
            const float rstd = rsqrtf(wave_sum(ss) * (1.0f / DM) + NORM_EPS);
            bf16* hr = H + (size_t)(m0 + r) * DM + 4 * F.lane;
#pragma unroll
            for (int j = 0; j < 8; ++j) { const f32x4 h = v[j] * rstd * av[j] + tv[j]; v2u w; w.x = cvt_pk_bf16(h[0], h[1]); w.y = cvt_pk_bf16(h[2], h[3]); *(v2u*)(hr + 256 * j) = w; }
#pragma unroll
            for (int j = 0; j < 8; ++j) v[j] = vn[j];
        }
    }
}

__device__ __forceinline__ void unpack8(LAS float* y, v4u w) { *(LAS f32x4*)y = (f32x4){bf_lo(w.x), bf_hi(w.x), bf_lo(w.y), bf_hi(w.y)}; *(LAS f32x4*)(y + 4) = (f32x4){bf_lo(w.z), bf_hi(w.z), bf_lo(w.w), bf_hi(w.w)}; }
__device__ __forceinline__ v4u pack8(const LAS float* y) { const f32x4 a = *(const LAS f32x4*)y, b = *(const LAS f32x4*)(y + 4); v4u w; w.x = cvt_pk_bf16(a[0], a[1]); w.y = cvt_pk_bf16(a[2], a[3]); w.z = cvt_pk_bf16(b[0], b[1]); w.w = cvt_pk_bf16(b[2], b[3]); return w; }
template <int NG, int LEN, int GS> __device__ __forceinline__ void norm_pass(LAS float* y, int start, const LAS float* g, int lane) {
    constexpr int LPG = 64 / NG, EPL = LEN / LPG; static_assert(LEN % LPG == 0, "norm_pass");
    const int grp = lane / LPG, li = lane % LPG; LAS float* yb = y + start + grp * GS + li;
    float v[EPL]; float ss = 0.f;
#pragma unroll
    for (int j = 0; j < EPL; ++j) { v[j] = yb[LPG * j]; ss += v[j] * v[j]; }
    ss = xsum<LPG>(ss);
    const float rstd = rsqrtf(ss * (1.0f / LEN) + NORM_EPS);
#pragma unroll
    for (int j = 0; j < EPL; ++j) yb[LPG * j] = v[j] * rstd * g[li + LPG * j];
}
__device__ __forceinline__ int post1_col(int i) { return i < 64 ? PC_QA + 8 * i : (i < 128 ? PC_KA + 8 * (i - 64) : (i < 184 ? PC_CQ + 8 * (i - 128) : (i < 200 ? PC_CKV + 8 * (i - 184) : PC_KR + 8 * (i - 200)))); }
__device__ __forceinline__ void post1_phase(Frame& F, KParams p, int l) {
    bf16* P = (bf16*)(p->ws + WS_P); const float* tab = (const float*)(p->ws + WS_TAB);
    LAS float* y = (LAS float*)(F.lds + F.wave * 8192);
    LAS float* G = (LAS float*)(F.lds + 65536);
    for (int i = F.tid; i < 896; i += 512) G[i] = i < 128 ? p->in[I_GQA][l * 128 + i] : (i < 256 ? p->in[I_GKA][l * 128 + i - 128] : (i < 704 ? p->in[I_GCQ][l * 448 + i - 256] : (i < 832 ? p->in[I_GCKV][l * 128 + i - 704] : p->in[I_GKR][l * 64 + i - 832])));
    __syncthreads();
    const int gw = F.vcu * NWAVES + F.wave, NGW = F.G * NWAVES, lane = F.lane;
    const int c1 = post1_col(lane + 64), c2 = post1_col(lane + 128), c3 = post1_col(lane < 16 ? lane + 192 : 192);
    v4u r1, r2, r3;
#define P1LOAD(m_) do { const bf16* row_ = P + (size_t)(m_) * NP; r1 = *(const v4u*)(row_ + c1); r2 = *(const v4u*)(row_ + c2); r3 = *(const v4u*)(row_ + c3); } while (0)
    if (gw < M) P1LOAD(gw);
    for (int m = gw; m < M; m += NGW) {
        const int t = m & (SEQ - 1); bf16* row = P + (size_t)m * NP;
        unpack8(y + 8 * (lane + 64), r1); unpack8(y + 8 * (lane + 128), r2); if (lane < 16) unpack8(y + 8 * (lane + 192), r3);
        const float* tb = tab + (size_t)t * 96;
        float rc[2], rs[2]; { const int i = lane & 15; rc[0] = tb[i]; rs[0] = tb[16 + i]; rc[1] = tb[32 + (lane & 31)]; rs[1] = tb[64 + (lane & 31)]; }
        if (m + NGW < M) P1LOAD(m + NGW);
        LDS_WAIT(); asm volatile("" ::: "memory");
        norm_pass<4, 128, 128>(y, 512, G + 128, lane); norm_pass<1, 448, 0>(y, 1024, G + 256, lane);
        {
          const int hf = lane >> 5, li = lane & 31; LAS float* yb = y + (hf ? 1600 : 1472) + li; const LAS float* gb = G + (hf ? 832 : 704) + li;
          const float v0 = yb[0], v1 = yb[32], v2 = hf ? 0.f : yb[64], v3 = hf ? 0.f : yb[96]; float ss = (v0 * v0 + v1 * v1) + (v2 * v2 + v3 * v3);
          ss = xsum<32>(ss);
          const float rstd = rsqrtf(ss * (hf ? 1.0f / 64 : 1.0f / 128) + NORM_EPS);
          yb[0] = v0 * rstd * gb[0]; yb[32] = v1 * rstd * gb[32]; if (!hf) { yb[64] = v2 * rstd * gb[64]; yb[96] = v3 * rstd * gb[96]; } }
        LDS_WAIT(); asm volatile("" ::: "memory");
#pragma unroll
        for (int k = 1; k < 2; ++k) { const int pr = lane + 64 * k, base = 128 * (pr >> 4), i = pr & 15; const float a = y[base + i], b = y[base + 16 + i], c = rc[0], s = rs[0];
            y[base + i] = a * c - b * s; y[base + 16 + i] = a * s + b * c; }
        if (lane < 32) { const float a = y[1600 + lane], b = y[1632 + lane], c = rc[1], s = rs[1]; y[1600 + lane] = a * c - b * s; y[1632 + lane] = a * s + b * c; }
        LDS_WAIT(); asm volatile("" ::: "memory");
        *(v4u*)(row + c1) = pack8(y + 8 * (lane + 64)); *(v4u*)(row + c2) = pack8(y + 8 * (lane + 128)); if (lane < 16) *(v4u*)(row + c3) = pack8(y + 8 * (lane + 192));
        LDS_WAIT(); asm volatile("" ::: "memory");
    }
#undef P1LOAD
}

namespace att {
constexpr int QBLK = 32, KVBLK = 64;
constexpr int SHM_V = 16384, SHM_K = 16384, SHM_KR = 8192;
constexpr int OFF_V = 0, OFF_K = 2 * SHM_V, OFF_KR = OFF_K + 2 * SHM_K, OFF_WS = OFF_KR + 2 * SHM_KR, OFF_QR = OFF_WS + NWAVES * 64 * 4, OFF_DONE = OFF_QR + NWAVES * 4096, SHM_ATTN = OFF_DONE + 16;
constexpr float L2E = 1.4426950408889634f;
#define KSWZ(row, colB) ((row) * 256 + ((colB) ^ (((row) & 7) << 4)))
#define KRSWZ(row, colB) ((row) * 128 + ((colB) ^ (((row) & 7) << 4)))
__device__ __forceinline__ int crow(int r, int hi) { return (r & 3) + 8 * (r >> 2) + 4 * hi; }
#ifndef ATT_PIPE_A
#define ATT_PIPE_A true
#endif
#ifndef ATT_SD_A
#define ATT_SD_A 2
#endif
#ifndef ATT_SD_B
#define ATT_SD_B 1
#endif
#ifndef ATT_PIPE_B
#define ATT_PIPE_B true
#endif
#ifndef ATT_PIPE_C
#define ATT_PIPE_C false
#endif
template <int MODE> struct Cfg;
template <> struct Cfg<0> { static constexpr float SCALE = 0.088388347648318440f; static constexpr int ND0 = 8, SDEPTH = ATT_SD_A; static constexpr bool PIPE = ATT_PIPE_A; };
template <> struct Cfg<1> { static constexpr float SCALE = 0.072168783648703220f; static constexpr int ND0 = 12, SDEPTH = ATT_SD_B; static constexpr bool PIPE = ATT_PIPE_B; };
template <> struct Cfg<2> { static constexpr float SCALE = 0.088388347648318440f; static constexpr int ND0 = 8, SDEPTH = 1; static constexpr bool PIPE = ATT_PIPE_C; };
constexpr float THR = 8.f;
template <int MODE> __device__ __forceinline__ void partialSM(f32x16& p0, f32x16& p1, float& m_reg, float& mn, float& alpha) {
    constexpr float SCALE = Cfg<MODE>::SCALE, C = SCALE * L2E;
    float pmax = p0[0];
#pragma unroll
    for (int r = 1; r < 16; ++r) pmax = fmaxf(pmax, p0[r]);
#pragma unroll
    for (int r = 0; r < 16; ++r) pmax = fmaxf(pmax, p1[r]);
    { auto rr = __builtin_amdgcn_permlane32_swap(__float_as_uint(pmax), __float_as_uint(pmax), false, false); pmax = fmaxf(__uint_as_float(rr[0]), __uint_as_float(rr[1])); }
    if (__builtin_expect(__all(pmax - m_reg <= THR / SCALE), 1)) { mn = m_reg; alpha = 1.f; }
    else { mn = fmaxf(m_reg, pmax); alpha = __builtin_amdgcn_exp2f((m_reg - mn) * C); m_reg = mn; }
    const float mnC = -mn * C;
#pragma unroll
    for (int r = 0; r < 16; ++r) p0[r] = fmaf(p0[r], C, mnC);
#pragma unroll
    for (int r = 0; r < 16; ++r) p1[r] = fmaf(p1[r], C, mnC);
#pragma unroll
    for (int r = 0; r < 16; ++r) p0[r] = __builtin_amdgcn_exp2f(p0[r]);
}
#define PK4(P, BASE, OUT) do { unsigned a0 = cvt_pk_bf16(P[BASE + 0], P[BASE + 1]), a1 = cvt_pk_bf16(P[BASE + 2], P[BASE + 3]);   \
    unsigned b0 = cvt_pk_bf16(P[BASE + 4], P[BASE + 5]), b1 = cvt_pk_bf16(P[BASE + 6], P[BASE + 7]);                              \
    auto r0 = __builtin_amdgcn_permlane32_swap(a0, b0, false, false); auto r1 = __builtin_amdgcn_permlane32_swap(a1, b1, false, false); \
    v4u w = {r0[0], r1[0], r0[1], r1[1]}; OUT = *reinterpret_cast<bf16x8*>(&w); } while (0)
__device__ __forceinline__ void finishSM(f32x16& p0, f32x16& p1, float alpha, float& l_reg, bf16x8& pa0, bf16x8& pa1, bf16x8& pa2, bf16x8& pa3) {
#pragma unroll
    for (int r = 0; r < 16; ++r) p1[r] = __builtin_amdgcn_exp2f(p1[r]);
    float ps = 0;
#pragma unroll
    for (int r = 0; r < 16; ++r) ps += p0[r];
#pragma unroll
    for (int r = 0; r < 16; ++r) ps += p1[r];
    { auto rr = __builtin_amdgcn_permlane32_swap(__float_as_uint(ps), __float_as_uint(ps), false, false); ps = __uint_as_float(rr[0]) + __uint_as_float(rr[1]); }
    l_reg = l_reg * alpha + ps;
    PK4(p0, 0, pa0); PK4(p0, 8, pa1); PK4(p1, 0, pa2); PK4(p1, 8, pa3);
}
__device__ __forceinline__ void packP(f32x16& p0, f32x16& p1, bf16x8& pa0, bf16x8& pa1, bf16x8& pa2, bf16x8& pa3) { PK4(p0, 0, pa0); PK4(p0, 8, pa1); PK4(p1, 0, pa2); PK4(p1, 8, pa3); }
__device__ __forceinline__ void stick_half(f32x16& p, const int cbase, const float Rin, float& T, const int lim2, const int hi, const float f0) {
    constexpr float SC = 0.088388347648318440f;
    float ls[16];
#pragma unroll
    for (int r = 0; r < 16; ++r) { const int c = (r & 3) + 8 * (r >> 2) + cbase;
        const float z = p[r] * SC; const float e = __builtin_amdgcn_exp2f(-fabsf(z) * L2E); const float sp = fmaxf(z, 0.f) + __builtin_amdgcn_logf(1.0f + e) * 0.6931471805599453f;
        p[r] = z; ls[r] = (c < lim2) ? -sp : 0.f; }
    float own[4], oth[4];
#pragma unroll
    for (int i = 0; i < 4; ++i) own[i] = (ls[4 * i] + ls[4 * i + 1]) + (ls[4 * i + 2] + ls[4 * i + 3]);
#pragma unroll
    for (int i = 0; i < 4; ++i) { auto rr = __builtin_amdgcn_permlane32_swap(__float_as_uint(own[i]), __float_as_uint(own[i]), false, false); oth[i] = hi ? __uint_as_float(rr[0]) : __uint_as_float(rr[1]); }
#pragma unroll
    for (int i = 3; i >= 0; --i) {
        const float l3 = Rin + T + oth[i] * f0;
        const int b = 4 * i, cb = 8 * i + cbase;
        const float l2 = l3 + ls[b + 3], l1 = l2 + ls[b + 2], l0 = l1 + ls[b + 1];
        p[b + 3] = (cb + 3 < lim2) ? __builtin_amdgcn_exp2f((p[b + 3] + ls[b + 3] + l3) * L2E) : 0.f; p[b + 2] = (cb + 2 < lim2) ? __builtin_amdgcn_exp2f((p[b + 2] + ls[b + 2] + l2) * L2E) : 0.f;
        p[b + 1] = (cb + 1 < lim2) ? __builtin_amdgcn_exp2f((p[b + 1] + ls[b + 1] + l1) * L2E) : 0.f; p[b + 0] = (cb + 0 < lim2) ? __builtin_amdgcn_exp2f((p[b + 0] + ls[b + 0] + l0) * L2E) : 0.f;
        T += own[i] + oth[i];
    }
}
__device__ __forceinline__ void stickSM(f32x16& p0, f32x16& p1, float& R, int lim2, int hi) {
    const float f0 = hi ? 0.f : 1.f; float T = 0.f;
    stick_half(p1, 32, R, T, lim2, hi, f0); asm volatile("" : "+v"(T));
    stick_half(p0, 0, R, T, lim2, hi, f0);
    R += T;
}
__device__ __forceinline__ void maskA(f32x16& p0, f32x16& p1, unsigned w0, unsigned w1, int hi) {
    const unsigned a = w0 >> (4 * hi), b = w1 >> (4 * hi);
#pragma unroll
    for (int r = 0; r < 16; ++r) { const unsigned bit = 1u << ((r & 3) + 8 * (r >> 2)); p0[r] = (a & bit) ? p0[r] : -INFINITY; p1[r] = (b & bit) ? p1[r] : -INFINITY; }
}
template <int ND0> __device__ __forceinline__ void qkt(f32x16& p0, f32x16& p1, const char* Ks, const char* Krs, const bf16x8* qr, const char* qrl, int r32, int hi) {
    p0 = f32x16{}; p1 = f32x16{};
#pragma unroll
    for (int d0 = 0; d0 < 8; ++d0) { const int cb = (d0 * 16 + hi * 8) * 2;
        const bf16x8 b0 = *reinterpret_cast<const bf16x8*>(Ks + KSWZ(r32, cb)), b1 = *reinterpret_cast<const bf16x8*>(Ks + KSWZ(32 + r32, cb));
        p0 = __builtin_amdgcn_mfma_f32_32x32x16_bf16(b0, qr[d0], p0, 0, 0, 0); p1 = __builtin_amdgcn_mfma_f32_32x32x16_bf16(b1, qr[d0], p1, 0, 0, 0); }
    if constexpr (ND0 == 12) {
#pragma unroll
        for (int d0 = 0; d0 < 4; ++d0) { const int cb = (d0 * 16 + hi * 8) * 2;
            const bf16x8 b0 = *reinterpret_cast<const bf16x8*>(Krs + KRSWZ(r32, cb)), b1 = *reinterpret_cast<const bf16x8*>(Krs + KRSWZ(32 + r32, cb));
            const bf16x8 qv = *reinterpret_cast<const bf16x8*>(qrl + d0 * 1024);
            p0 = __builtin_amdgcn_mfma_f32_32x32x16_bf16(b0, qv, p0, 0, 0, 0); p1 = __builtin_amdgcn_mfma_f32_32x32x16_bf16(b1, qv, p1, 0, 0, 0); } }
}
__device__ __forceinline__ int v_st(int k, int c) { const int kk = (k & ~0xC) | ((k & 4) << 1) | ((k & 8) >> 1); return ((kk >> 3) * 4 + (c >> 5)) * 512 + ((kk & 7) * 32 + (c & 31)) * 2; }
__device__ __forceinline__ int v_rd_base(int lane) { return ((lane & 3) << 3) | (((lane >> 2) & 3) << 6) | (((lane >> 4) & 1) << 5) | (((lane >> 5) & 1) << 8); }
constexpr int v_rd_off(int d0, int ks, int half) { return d0 * 512 + ks * 4096 + half * 2048; }
template <int OFF> __device__ __forceinline__ s16x4 tr_read(int vb) { s16x4 r; asm volatile("ds_read_b64_tr_b16 %0, %1 offset:%2" : "=&v"(r) : "v"(vb), "i"(OFF) : "memory"); return r; }
template <int D0> __device__ __forceinline__ void pv_one(f32x16& od, int vb, bf16x8 pa0, bf16x8 pa1, bf16x8 pa2, bf16x8 pa3) {
    const s16x4 l0 = tr_read<v_rd_off(D0, 0, 0)>(vb), h0 = tr_read<v_rd_off(D0, 0, 1)>(vb), l1 = tr_read<v_rd_off(D0, 1, 0)>(vb), h1 = tr_read<v_rd_off(D0, 1, 1)>(vb);
    const s16x4 l2 = tr_read<v_rd_off(D0, 2, 0)>(vb), h2 = tr_read<v_rd_off(D0, 2, 1)>(vb), l3 = tr_read<v_rd_off(D0, 3, 0)>(vb), h3 = tr_read<v_rd_off(D0, 3, 1)>(vb);
    asm volatile("s_waitcnt lgkmcnt(0)" ::: "memory"); SBAR();
#define PKV(L, H) (bf16x8){L[0], L[1], L[2], L[3], H[0], H[1], H[2], H[3]}
    od = __builtin_amdgcn_mfma_f32_32x32x16_bf16(pa0, PKV(l0, h0), od, 0, 0, 0);
    od = __builtin_amdgcn_mfma_f32_32x32x16_bf16(pa1, PKV(l1, h1), od, 0, 0, 0);
    od = __builtin_amdgcn_mfma_f32_32x32x16_bf16(pa2, PKV(l2, h2), od, 0, 0, 0);
    od = __builtin_amdgcn_mfma_f32_32x32x16_bf16(pa3, PKV(l3, h3), od, 0, 0, 0);
#undef PKV
}
__device__ __forceinline__ void pv_d0(f32x16* o, int vb, bf16x8 pa0, bf16x8 pa1, bf16x8 pa2, bf16x8 pa3) {
    pv_one<0>(o[0], vb, pa0, pa1, pa2, pa3); pv_one<1>(o[1], vb, pa0, pa1, pa2, pa3); pv_one<2>(o[2], vb, pa0, pa1, pa2, pa3); pv_one<3>(o[3], vb, pa0, pa1, pa2, pa3);
}

template <int MODE>
__device__ __forceinline__ void attn_unit(const bf16* __restrict__ Qb, int ldq, const bf16* __restrict__ Kh, const bf16* __restrict__ Vh, int ldk, const bf16* __restrict__ Krh,
                                          bf16* __restrict__ Ob, int ldo, int NT, int t0, const unsigned* __restrict__ mrow, char* lds, int wv,
                                          const float* __restrict__ gqn = nullptr, const float* __restrict__ gqr = nullptr, const float* __restrict__ tab = nullptr) {
    constexpr int ND0 = Cfg<MODE>::ND0, SDEPTH = Cfg<MODE>::SDEPTH;
    int wv_ = wv; asm volatile("" : "+s"(wv_)); int tid_ = (wv_ << 6) | lane_id_fresh(); tid_ &= 511;
    const int tid = tid_, wid = tid >> 6, lane = tid & 63, r32 = lane & 31, hi = lane >> 5;
    if (wv_ >= 4) __builtin_amdgcn_s_setprio(1);
    char* V_lds = lds + OFF_V; char* K_lds = lds + OFF_K; char* KR_lds = lds + OFF_KR;
    float* ws = (float*)(lds + OFF_WS) + wid * 64; float* li_l = ws; float* al_l = ws + 32;
    float m_reg = -1e30f, l_reg = 0.f, R = 0.f; f32x16 o[4] = {}; bf16x8 qr[8];
    const bf16* Qw = Qb + (size_t)(wid * QBLK + r32) * ldq + hi * 8;
    char* qrl = lds + OFF_QR + wid * 4096 + lane * 16;
    if constexpr (MODE == 0 || MODE == 1) {
        float qf[8][8]; float ss = 0.f;
#pragma unroll
        for (int d0 = 0; d0 < 8; ++d0) { const v4u w = *reinterpret_cast<const v4u*>(Qw + d0 * 16);
            qf[d0][0] = bf_lo(w.x); qf[d0][1] = bf_hi(w.x); qf[d0][2] = bf_lo(w.y); qf[d0][3] = bf_hi(w.y); qf[d0][4] = bf_lo(w.z); qf[d0][5] = bf_hi(w.z); qf[d0][6] = bf_lo(w.w); qf[d0][7] = bf_hi(w.w); }
#pragma unroll
        for (int d0 = 0; d0 < 8; ++d0)
#pragma unroll
            for (int j = 0; j < 8; ++j) ss += qf[d0][j] * qf[d0][j];
        { auto r = __builtin_amdgcn_permlane32_swap(__float_as_uint(ss), __float_as_uint(ss), false, false); ss = __uint_as_float(r[0]) + __uint_as_float(r[1]); }
        const float rstd = rsqrtf(ss * (1.0f / 128) + NORM_EPS);
        const float* tb = tab + (size_t)(t0 + wid * QBLK + r32) * 96;
#pragma unroll
        for (int d0 = 0; d0 < 8; ++d0) { const f32x4 g0 = *reinterpret_cast<const f32x4*>(gqn + d0 * 16 + hi * 8), g1 = *reinterpret_cast<const f32x4*>(gqn + d0 * 16 + hi * 8 + 4);
#pragma unroll
            for (int j = 0; j < 4; ++j) { qf[d0][j] = qf[d0][j] * rstd * g0[j]; qf[d0][4 + j] = qf[d0][4 + j] * rstd * g1[j]; } }
        if constexpr (MODE == 0) {
            const int i0 = hi * 8;
            const f32x4 c0 = *reinterpret_cast<const f32x4*>(tb + i0), c1 = *reinterpret_cast<const f32x4*>(tb + i0 + 4), s0 = *reinterpret_cast<const f32x4*>(tb + 16 + i0), s1 = *reinterpret_cast<const f32x4*>(tb + 16 + i0 + 4);
#pragma unroll
            for (int j = 0; j < 8; ++j) { const float c = j < 4 ? c0[j & 3] : c1[j & 3], s = j < 4 ? s0[j & 3] : s1[j & 3], a = qf[0][j], b = qf[1][j];
                qf[0][j] = a * c - b * s; qf[1][j] = a * s + b * c; }
        }
#pragma unroll
        for (int d0 = 0; d0 < 8; ++d0) { v4u w; w.x = cvt_pk_bf16(qf[d0][0], qf[d0][1]); w.y = cvt_pk_bf16(qf[d0][2], qf[d0][3]); w.z = cvt_pk_bf16(qf[d0][4], qf[d0][5]); w.w = cvt_pk_bf16(qf[d0][6], qf[d0][7]);
            qr[d0] = *reinterpret_cast<bf16x8*>(&w); }
        if constexpr (MODE == 1) {
            float rf[4][8]; float s2 = 0.f;
#pragma unroll
            for (int d0 = 0; d0 < 4; ++d0) { const v4u w = *reinterpret_cast<const v4u*>(Qw + (8 + d0) * 16);
                rf[d0][0] = bf_lo(w.x); rf[d0][1] = bf_hi(w.x); rf[d0][2] = bf_lo(w.y); rf[d0][3] = bf_hi(w.y); rf[d0][4] = bf_lo(w.z); rf[d0][5] = bf_hi(w.z); rf[d0][6] = bf_lo(w.w); rf[d0][7] = bf_hi(w.w); }
#pragma unroll
            for (int d0 = 0; d0 < 4; ++d0)
#pragma unroll
                for (int j = 0; j < 8; ++j) s2 += rf[d0][j] * rf[d0][j];
            { auto r = __builtin_amdgcn_permlane32_swap(__float_as_uint(s2), __float_as_uint(s2), false, false); s2 = __uint_as_float(r[0]) + __uint_as_float(r[1]); }
            const float rstd2 = rsqrtf(s2 * (1.0f / 64) + NORM_EPS);
#pragma unroll
            for (int d0 = 0; d0 < 4; ++d0) { const f32x4 g0 = *reinterpret_cast<const f32x4*>(gqr + d0 * 16 + hi * 8), g1 = *reinterpret_cast<const f32x4*>(gqr + d0 * 16 + hi * 8 + 4);
#pragma unroll
                for (int j = 0; j < 4; ++j) { rf[d0][j] = rf[d0][j] * rstd2 * g0[j]; rf[d0][4 + j] = rf[d0][4 + j] * rstd2 * g1[j]; } }
#pragma unroll
            for (int d0 = 0; d0 < 2; ++d0) { const int i0 = d0 * 16 + hi * 8;
                const f32x4 c0 = *reinterpret_cast<const f32x4*>(tb + 32 + i0), c1 = *reinterpret_cast<const f32x4*>(tb + 32 + i0 + 4), s0 = *reinterpret_cast<const f32x4*>(tb + 64 + i0), s1 = *reinterpret_cast<const f32x4*>(tb + 64 + i0 + 4);
#pragma unroll
                for (int j = 0; j < 8; ++j) { const float c = j < 4 ? c0[j & 3] : c1[j & 3], s = j < 4 ? s0[j & 3] : s1[j & 3], a = rf[d0][j], b = rf[d0 + 2][j];
                    rf[d0][j] = a * c - b * s; rf[d0 + 2][j] = a * s + b * c; } }
#pragma unroll
            for (int d0 = 0; d0 < 4; ++d0) { v4u w; w.x = cvt_pk_bf16(rf[d0][0], rf[d0][1]); w.y = cvt_pk_bf16(rf[d0][2], rf[d0][3]); w.z = cvt_pk_bf16(rf[d0][4], rf[d0][5]); w.w = cvt_pk_bf16(rf[d0][6], rf[d0][7]);
                *reinterpret_cast<v4u*>(qrl + d0 * 1024) = w; }
        }
    } else {
#pragma unroll
        for (int d0 = 0; d0 < 8; ++d0) qr[d0] = *reinterpret_cast<const bf16x8*>(Qw + d0 * 16);
    }
    const int sr = tid >> 4, sc = (tid & 15) * 8, vst0 = v_st(sr, sc), vst1 = v_st(32 + sr, sc);
    const int krr = tid >> 3, krc = (tid & 7) * 8;
    const int vb0 = (int)(uintptr_t)V_lds + v_rd_base(lane);
    const int cw = (t0 >> 6) + (wid >> 1);
    const unsigned* mlane = mrow + (size_t)(wid * QBLK + r32) * 128;
    struct { bf16x8 vs0, vs1, ks0, ks1, kr; } sr_[SDEPTH];
#define TILE(j) (MODE == 2 ? (NT - 1 - (j)) : (j))
#define SLOAD(i, j) do { const int k0_ = TILE(j) * KVBLK; sr_[i].vs0 = *reinterpret_cast<const bf16x8*>(&Vh[(size_t)(k0_ + sr) * ldk + sc]); sr_[i].vs1 = *reinterpret_cast<const bf16x8*>(&Vh[(size_t)(k0_ + 32 + sr) * ldk + sc]); \
    sr_[i].ks0 = *reinterpret_cast<const bf16x8*>(&Kh[(size_t)(k0_ + sr) * ldk + sc]); sr_[i].ks1 = *reinterpret_cast<const bf16x8*>(&Kh[(size_t)(k0_ + 32 + sr) * ldk + sc]); \
    if constexpr (MODE == 1) sr_[i].kr = *reinterpret_cast<const bf16x8*>(&Krh[(size_t)(k0_ + krr) * NP + krc]); } while (0)
#define SWRITE(b, i) do { *(bf16x8*)(V_lds + (b) * SHM_V + vst0) = sr_[i].vs0; *(bf16x8*)(V_lds + (b) * SHM_V + vst1) = sr_[i].vs1; const int kc_ = sc * 2;   \
    *(bf16x8*)(K_lds + (b) * SHM_K + KSWZ(sr, kc_)) = sr_[i].ks0; *(bf16x8*)(K_lds + (b) * SHM_K + KSWZ(32 + sr, kc_)) = sr_[i].ks1;               \
    if constexpr (MODE == 1) *(bf16x8*)(KR_lds + (b) * SHM_KR + KRSWZ(krr, krc * 2)) = sr_[i].kr; } while (0)
#define SWAIT() do { if constexpr (SDEPTH == 2) asm volatile("s_waitcnt vmcnt(4)" ::: "memory"); else asm volatile("s_waitcnt vmcnt(0)" ::: "memory"); } while (0)
#define RESC(a) do { if constexpr (MODE != 2) { if (__any((a) < 1.f)) { if (hi == 0) al_l[r32] = (a); asm volatile("s_waitcnt lgkmcnt(0)" ::: "memory"); \
    _Pragma("unroll") for (int d = 0; d < 4; ++d) _Pragma("unroll") for (int r = 0; r < 16; ++r) o[d][r] *= al_l[crow(r, hi)]; } } } while (0)
#define MLOAD(w0, w1, j) do { if constexpr (MODE == 0) { const v2u mw_ = *reinterpret_cast<const v2u*>(mlane + 2 * TILE(j)); w0 = mw_.x; w1 = mw_.y; } } while (0)
#define PART(P0, P1, MN, AL, w0, w1, j) do { const int jj_ = TILE(j); \
    if constexpr (MODE == 0) { maskA(P0, P1, w0, w1, hi); partialSM<0>(P0, P1, m_reg, MN, AL); } \
    else if constexpr (MODE == 1) { if (jj_ > cw) { _Pragma("unroll") for (int r = 0; r < 16; ++r) { P0[r] = -INFINITY; P1[r] = -INFINITY; } } partialSM<1>(P0, P1, m_reg, MN, AL); } \
    else { const int lim_ = jj_ < cw ? 64 : (jj_ > cw ? 0 : 32 * (wid & 1) + r32); stickSM(P0, P1, R, lim_ - 4 * hi, hi); } } while (0)
#define FIN(P0, P1, AL) do { if constexpr (MODE == 2) packP(P0, P1, pa0, pa1, pa2, pa3); else finishSM(P0, P1, AL, l_reg, pa0, pa1, pa2, pa3); } while (0)
    f32x16 pA0, pA1; float mnA = 0.f, alA = 1.f; bf16x8 pa0, pa1, pa2, pa3; unsigned mA0 = 0, mA1 = 0;
    (void)mnA;
    if constexpr (!Cfg<MODE>::PIPE) {
    volatile LAS unsigned* dn = (volatile LAS unsigned*)(lds + OFF_DONE); int ds = 0;
    if constexpr (MODE == 2) { if (tid < 3) dn[tid] = 0u; }
    SLOAD(0, 0); asm volatile("s_waitcnt vmcnt(0)" ::: "memory"); SWRITE(0, 0); __syncthreads();
    for (int j = 0; j < NT; ++j) {
        const int buf = j & 1;
        MLOAD(mA0, mA1, j);
        if (j + 1 < NT) SLOAD(0, j + 1);
        SBAR();
        qkt<ND0>(pA0, pA1, K_lds + buf * SHM_K, KR_lds + buf * SHM_KR, qr, qrl, r32, hi);
        PART(pA0, pA1, mnA, alA, mA0, mA1, j);
        FIN(pA0, pA1, alA);
        RESC(alA);
        SBAR();
        pv_d0(o, vb0 + buf * SHM_V, pa0, pa1, pa2, pa3);
        if (j + 1 < NT) { asm volatile("s_waitcnt vmcnt(0)" ::: "memory"); SWRITE(buf ^ 1, 0); }
        if constexpr (MODE == 2) { if (__all(R < -120.f) && lane == 0) __hip_atomic_fetch_add((LAS unsigned*)(lds + OFF_DONE) + ds, 1u, __ATOMIC_RELAXED, __HIP_MEMORY_SCOPE_WORKGROUP); }
        __syncthreads();
        if constexpr (MODE == 2) { const unsigned c_ = dn[ds]; const int zs = ds == 0 ? 2 : ds - 1; if (tid == 0) dn[zs] = 0u; ds = ds == 2 ? 0 : ds + 1; if (c_ == NWAVES) break; }
    }
    } else {
    f32x16 pB0, pB1; float mnB = 0.f, alB = 1.f; unsigned mB0 = 0, mB1 = 0; (void)mnB;
    constexpr int SE = 0, SO = SDEPTH - 1;
    SLOAD(SE, 0); MLOAD(mA0, mA1, 0); asm volatile("s_waitcnt vmcnt(0)" ::: "memory"); SWRITE(0, SE); __syncthreads();
    qkt<ND0>(pA0, pA1, K_lds, KR_lds, qr, qrl, r32, hi); PART(pA0, pA1, mnA, alA, mA0, mA1, 0);
    SLOAD(SO, 1); if constexpr (SDEPTH == 2) { if (2 < NT) SLOAD(SE, 2); }
    SWAIT(); SWRITE(1, SO); __syncthreads();
    for (int j = 1; j + 1 < NT; j += 2) {
        SBAR(); MLOAD(mB0, mB1, j); qkt<ND0>(pB0, pB1, K_lds + SHM_K, KR_lds + SHM_KR, qr, qrl, r32, hi);
        FIN(pA0, pA1, alA); SBAR();
        SLOAD(SO, j + SDEPTH); SBAR();
        pv_d0(o, vb0, pa0, pa1, pa2, pa3); PART(pB0, pB1, mnB, alB, mB0, mB1, j);
        __syncthreads(); SWAIT(); SWRITE(0, SE);
        RESC(alB); __syncthreads();
        SBAR(); MLOAD(mA0, mA1, j + 1); qkt<ND0>(pA0, pA1, K_lds, KR_lds, qr, qrl, r32, hi);
        FIN(pB0, pB1, alB); SBAR();
        if (SDEPTH == 1 || j + 3 < NT) SLOAD(SE, j + 1 + SDEPTH); SBAR();
        pv_d0(o, vb0 + SHM_V, pa0, pa1, pa2, pa3); PART(pA0, pA1, mnA, alA, mA0, mA1, j + 1);
        __syncthreads(); SWAIT(); SWRITE(1, SO);
        RESC(alA); __syncthreads();
    }
    SBAR(); MLOAD(mB0, mB1, NT - 1); qkt<ND0>(pB0, pB1, K_lds + SHM_K, KR_lds + SHM_KR, qr, qrl, r32, hi);
    FIN(pA0, pA1, alA); SBAR();
    pv_d0(o, vb0, pa0, pa1, pa2, pa3); PART(pB0, pB1, mnB, alB, mB0, mB1, NT - 1);
    __syncthreads(); RESC(alB);
    FIN(pB0, pB1, alB); SBAR();
    pv_d0(o, vb0 + SHM_V, pa0, pa1, pa2, pa3);
    __syncthreads();
    }
    float rli[16];
    if constexpr (MODE != 2) { if (hi == 0) li_l[r32] = l_reg; asm volatile("s_waitcnt lgkmcnt(0)" ::: "memory");
#pragma unroll
        for (int r = 0; r < 16; ++r) rli[r] = __builtin_amdgcn_rcpf(li_l[crow(r, hi)]); }
    else {
#pragma unroll
        for (int r = 0; r < 16; ++r) rli[r] = 1.f; }
    bf16* Ow = Ob + (size_t)(wid * QBLK) * ldo;
    LAS unsigned char* ot = (LAS unsigned char*)lds + wid * 8192;
#pragma unroll
    for (int r = 0; r < 16; ++r) { const int orow = crow(r, hi);
#pragma unroll
        for (int d0 = 0; d0 < 4; ++d0) *(LAS bf16*)(ot + orow * 256 + (d0 * 32 + r32) * 2) = (bf16)(cvt_pk_bf16(o[d0][r] * rli[r], 0.f) & 0xffffu); }
    asm volatile("s_waitcnt lgkmcnt(0)" ::: "memory");
#pragma unroll
    for (int k = 0; k < 8; ++k) { const int row = 4 * k + (lane >> 4), cp = lane & 15;
        const v4u v = *(const LAS v4u*)(ot + row * 256 + cp * 16); *(v4u*)(Ow + (size_t)row * ldo + cp * 8) = v; }
    __builtin_amdgcn_s_setprio(0);
    __syncthreads();
#undef TILE
#undef SLOAD
#undef SWRITE
#undef SWAIT
#undef RESC
#undef MLOAD
#undef PART
#undef FIN
}
}

__device__ __forceinline__ unsigned ordkey(float f) { const unsigned u = __float_as_uint(f); return u ^ ((unsigned)((int)u >> 31) | 0x80000000u); }
__device__ __forceinline__ unsigned keyinv(unsigned k) { return k ^ ((unsigned)(~((int)k >> 31)) | 0x80000000u); }
__device__ __forceinline__ void indexer_unit(KParams p, int b, int u16, LAS unsigned char* lds, int tid) {
    const int wave = __builtin_amdgcn_readfirstlane(tid >> 6), lane = tid & 63, r32 = lane & 31, hi = lane >> 5;
    const int t0 = 16 * u16, m0 = b * SEQ + t0, c = t0 >> 6, ng = 2 * (c + 1), ntile = (ng + 7) >> 3;
    const bf16* P = (const bf16*)(p->ws + WS_P); const bf16* KI = P + (size_t)b * SEQ * NP + PC_KI; unsigned* MASK = (unsigned*)(p->ws + WS_MASK);
    bf16x8 aq[4];
    { const bf16* qp = P + (size_t)(m0 + 2 * wave + (r32 >> 4)) * NP + PC_QI + (r32 & 15) * 64 + 8 * hi;
#pragma unroll
      for (int s = 0; s < 4; ++s) aq[s] = *reinterpret_cast<const bf16x8*>(qp + 16 * s); }
    float wv[16];
#pragma unroll
    for (int r = 0; r < 16; ++r) { const int q = r >> 3, h = (r & 3) + 8 * ((r >> 2) & 1) + 4 * hi; wv[r] = __uint_as_float((unsigned)P[(size_t)(m0 + 2 * wave + q) * NP + PC_WI + h] << 16) * 0.03125f; }
    unsigned kx[128];
#pragma unroll
    for (int g = 0; g < 128; ++g) kx[g] = 0u;
    const int dkey = lane >> 3, dslot = lane & 7;
#define ILOAD(T, buf) do { _Pragma("unroll") for (int k = 0; k < 4; ++k) { const int key = 32 * wave + 8 * k + dkey; \
        __builtin_amdgcn_global_load_lds((const unsigned*)(KI + (size_t)((T) * 256 + key) * NP + 8 * (dslot ^ ((key >> 1) & 7))), (LAS unsigned*)(lds + (buf) * 32768 + 4096 * wave + 1024 * k), 16, 0, 0); } } while (0)
    ILOAD(0, 0);
    if (ntile > 1) { ILOAD(1, 1); asm volatile("s_waitcnt vmcnt(4)" ::: "memory"); } else { asm volatile("s_waitcnt vmcnt(0)" ::: "memory"); }
    __syncthreads();
    int cb = 0;
#pragma unroll 1
    for (int T = 0; T < ntile; ++T) {
        const bool more = T + 2 < ntile;
        if (more) { const int nb = cb == 0 ? 2 : cb - 1; ILOAD(T + 2, nb); }
        const LAS unsigned char* kb = lds + cb * 32768;
#pragma unroll
        for (int hf = 0; hf < 2; ++hf) {
        unsigned tk[4];
#define IDX_MMA(ACC, gi_) do { const LAS unsigned char* kr_ = kb + ((gi_) * 32 + r32) * 128; const int sw_ = (r32 >> 1) & 7; bf16x8 kf_[4]; \
            _Pragma("unroll") for (int s = 0; s < 4; ++s) kf_[s] = *(const LAS bf16x8*)(kr_ + (((2 * s + hi) ^ sw_) << 4)); \
            __builtin_amdgcn_s_setprio(1); ACC = f32x16{}; \
            _Pragma("unroll") for (int s = 0; s < 4; ++s) ACC = __builtin_amdgcn_mfma_f32_32x32x16_bf16(aq[s], kf_[s], ACC, 0, 0, 0); \
            __builtin_amdgcn_s_setprio(0); } while (0)
#define IDX_RELU(x) __int_as_float(max(__float_as_int(x), 0))
#define IDX_SCORE(ACC, g4_) do { float s0_ = 0.f, s1_ = 0.f; \
            _Pragma("unroll") for (int r = 0; r < 8; ++r) { s0_ = fmaf(wv[r], IDX_RELU(ACC[r]), s0_); s1_ = fmaf(wv[8 + r], IDX_RELU(ACC[8 + r]), s1_); } \
            auto rr_ = __builtin_amdgcn_permlane32_swap(__float_as_uint(s0_), __float_as_uint(s1_), false, false); \
            tk[g4_] = (T * 8 + 4 * hf + (g4_) < ng) ? ordkey(__uint_as_float(rr_[0]) + __uint_as_float(rr_[1])) : 0u; } while (0)
        f32x16 accA, accB;
        IDX_MMA(accA, 4 * hf + 0);
        IDX_MMA(accB, 4 * hf + 1); IDX_SCORE(accA, 0);
        IDX_MMA(accA, 4 * hf + 2); IDX_SCORE(accB, 1);
        IDX_MMA(accB, 4 * hf + 3); IDX_SCORE(accA, 2);
        IDX_SCORE(accB, 3);
#undef IDX_MMA
#undef IDX_RELU
#undef IDX_SCORE
        switch (T) {
#define KXCASE(n) case n: _Pragma("unroll") for (int i = 0; i < 4; ++i) kx[8 * n + 4 * hf + i] = tk[i]; break;
            KXCASE(0) KXCASE(1) KXCASE(2) KXCASE(3) KXCASE(4) KXCASE(5) KXCASE(6) KXCASE(7) KXCASE(8) KXCASE(9) KXCASE(10) KXCASE(11) KXCASE(12) KXCASE(13) KXCASE(14) KXCASE(15)
#undef KXCASE
            default: break;
        }
        }
        if (more) asm volatile("s_waitcnt vmcnt(4)" ::: "memory"); else asm volatile("s_waitcnt vmcnt(0)" ::: "memory");
        __syncthreads();
        cb = cb == 2 ? 0 : cb + 1;
    }
#undef ILOAD
    unsigned Tk = 0u;
    if (ng > 8) {
        unsigned kmax = 0u, kmn1 = 0xffffffffu;
#pragma unroll
        for (int gg = 0; gg < 16; ++gg) if (8 * gg < ng) {
#pragma unroll
            for (int k = 0; k < 8; ++k) { kmax = max(kmax, kx[8 * gg + k]); kmn1 = min(kmn1, kx[8 * gg + k] - 1u); } }
        kmax = xmax_u<32>(kmax); kmn1 = xmin_u<32>(kmn1);
        unsigned lo_k = kmn1 + 1u, hi_k = kmax + 1u;
        float dlo = (float)(32 * ng - 256) + 0.5f, dhi = 255.5f;
        int side = 0;
        bool done = false;
        if (hi_k - lo_k <= 1u) { Tk = lo_k; done = true; }
        for (int it = 0; it < 96; ++it) {
            const unsigned wd = hi_k - lo_k;
            const float frac = dlo * __builtin_amdgcn_rcpf(dlo + dhi);
            const float flo = __uint_as_float(keyinv(lo_k)), fhi = __uint_as_float(keyinv(min(hi_k, 0xff7fffffu)));
            unsigned Tt = wd < (1u << 23) ? lo_k + (unsigned)((float)wd * frac) : ordkey(flo + (fhi - flo) * frac);
            if (it >= 16) Tt = lo_k + (wd >> 1);
            Tt = min(max(Tt, lo_k + 1u), hi_k - 1u);
            if (done) Tt = Tk;
            int c4[4] = {0, 0, 0, 0};
#pragma unroll
            for (int gg = 0; gg < 16; ++gg) if (8 * gg < ng) {
#pragma unroll
                for (int k = 0; k < 8; ++k) c4[k & 3] += (kx[8 * gg + k] >= Tt) ? 1 : 0; }
            int cnt = (c4[0] + c4[1]) + (c4[2] + c4[3]);
            cnt = xsum_i<32>(cnt);
            if (!done) {
                if (cnt == 256) { Tk = Tt; done = true; }
                else if (cnt > 256) { lo_k = Tt; dlo = (float)(cnt - 256) + 0.5f; if (side == 1) dhi *= 0.5f; side = 1; }
                else { hi_k = Tt; dhi = (float)(256 - cnt) - 0.5f; if (side == 2) dlo *= 0.5f; side = 2; }
                if (!done && hi_k - lo_k <= 1u) { Tk = lo_k; done = true; }
            }
            if (__all(done)) break;
        }
    }
    unsigned wa0 = 0u, wa1 = 0u, wb0 = 0u, wb1 = 0u;
#pragma unroll
    for (int g = 0; g < 128; ++g) if (g < ng) {
        const unsigned long long bal = __ballot(kx[g] >= Tk);
        const unsigned lo = (unsigned)bal, hh = (unsigned)(bal >> 32);
        if (g < 64) { asm volatile("s_nop 1\n\tv_writelane_b32 %0, %1, %2" : "+v"(wa0) : "s"(lo), "n"(g & 63)); asm volatile("s_nop 1\n\tv_writelane_b32 %0, %1, %2" : "+v"(wa1) : "s"(hh), "n"(g & 63)); }
        else { asm volatile("s_nop 1\n\tv_writelane_b32 %0, %1, %2" : "+v"(wb0) : "s"(lo), "n"(g & 63)); asm volatile("s_nop 1\n\tv_writelane_b32 %0, %1, %2" : "+v"(wb1) : "s"(hh), "n"(g & 63)); }
    }
    unsigned* mr = MASK + (size_t)(m0 + 2 * wave) * 128;
    mr[lane] = wa0; mr[64 + lane] = wb0; mr[128 + lane] = wa1; mr[192 + lane] = wb1;
}

constexpr int NB_UNITS = NB * 8 * 16, NC_UNITS = NB * 4 * 16, NI_UNITS = NB * 256, P9_ITEMS = NB_UNITS + NC_UNITS, NA_UNITS = NB * 4 * 16;
__device__ __forceinline__ void attn_phase_all(Frame& F, KParams p, int qid, int l) {
    const float* gqa = p->in[I_GQA] + l * 128; const float* gqn = p->in[I_GQN] + l * 128; const float* gqr = p->in[I_GQR] + l * 64; const float* tab = (const float*)(p->ws + WS_TAB);
    const bf16* P = (const bf16*)(p->ws + WS_P); const bf16* QB = (const bf16*)(p->ws + WS_QB); const bf16* KVB = (const bf16*)(p->ws + WS_KVB); bf16* MIX = (bf16*)(p->ws + WS_H); const unsigned* MASK = (const unsigned*)(p->ws + WS_MASK);
    for (int it = q_next(F, qid); it < NB_UNITS + NC_UNITS + NA_UNITS; it = q_next(F, qid)) {
        const int lvl = it >> 7, r = it & 127, qb = 15 - lvl;
        if (r < 64) { const int b = r >> 3, h = r & 7; const size_t m0 = (size_t)b * SEQ + qb * 256, k0 = (size_t)b * SEQ;
            att::attn_unit<1>(QB + m0 * NQB + h * 192, NQB, KVB + k0 * NKVB + h * 256, KVB + k0 * NKVB + h * 256 + 128, NKVB, P + k0 * NP + PC_KR, MIX + m0 * DM + 512 + h * 128, DM, 4 * (qb + 1), qb * 256, nullptr, (char*)F.lds, F.wave, gqn, gqr, tab);
        } else if (r < 96) { const int bh = r - 64, b = bh >> 2, h = bh & 3; const size_t m0 = (size_t)b * SEQ + qb * 256, k0 = (size_t)b * SEQ;
            att::attn_unit<2>(P + m0 * NP + PC_QC + h * 128, NP, P + k0 * NP + PC_KC + h * 128, P + k0 * NP + PC_VC + h * 128, NP, nullptr, MIX + m0 * DM + 1536 + h * 128, DM, 4 * (qb + 1), qb * 256, nullptr, (char*)F.lds, F.wave);
        } else { const int bh = r - 96, b = bh >> 2, h = bh & 3; const size_t m0 = (size_t)b * SEQ + qb * 256, k0 = (size_t)b * SEQ;
            att::attn_unit<0>(P + m0 * NP + PC_QA + h * 128, NP, P + k0 * NP + PC_KA + h * 128, P + k0 * NP + PC_VA + h * 128, NP, nullptr, MIX + m0 * DM + h * 128, DM, 4 * (qb + 1), qb * 256, MASK + m0 * 128, (char*)F.lds, F.wave, gqa, nullptr, tab);
        }
    }
}
__device__ __forceinline__ void indexer_phase(Frame& F, KParams p, int qid) {
    for (int it = q_next(F, qid); it < NI_UNITS; it = q_next(F, qid)) { const int u16 = 255 - it / 8, b = it % 8; indexer_unit(p, b, u16, F.lds, F.tid); }
}

#ifndef FFN_SPLIT
#define FFN_SPLIT 1
#endif
constexpr int N_PHASES = 25 + 8 * (FFN_SPLIT - 1);
#ifndef WGM_RESID
#define WGM_RESID 4
#endif

__global__ void __launch_bounds__(NWAVES * 64, 2) mega_fwd(Params p_unused) {
    KParams p = (KParams)__builtin_amdgcn_kernarg_segment_ptr();
#ifndef CODE_SHIFT_NOPS
#define CODE_SHIFT_NOPS 12
#endif
    asm volatile(".rept %0\n\ts_nop 0\n\t.endr" :: "n"(CODE_SHIFT_NOPS));
    extern __shared__ __attribute__((aligned(16))) unsigned char lds_raw[];
    Frame F;
    F.lds = (LAS unsigned char*)lds_raw; F.MISC = (volatile LAS unsigned*)(F.lds + MISC_OFF);
    F.tid = threadIdx.x; F.lane = F.tid & 63; F.wave = __builtin_amdgcn_readfirstlane(F.tid >> 6); F.wave0 = F.wave;
    F.G = gridDim.x; { const int bx = blockIdx.x; F.vcu = (F.G % 8 == 0) ? (bx % 8) * (F.G / 8) + bx / 8 : bx; }
    F.ctl = (gu32*)(p->ws + WS_CTL);
    for (int u = F.tid; u < (LDS_BYTES - LDSCTL_OFF) / 4; u += NWAVES * 64) ((LAS unsigned*)(F.lds + LDSCTL_OFF))[u] = 0u;
    __syncthreads();
    const int lo = p->ph_lo, hi = p->ph_hi;
    XcdBarrier bar; bar.bar = (unsigned*)(F.ctl + CW_BAR); bar.x = 0; bar.st = nullptr;
    if (hi - lo > 1) bar = xcd_barrier_post((unsigned*)(F.ctl + CW_BAR), F.MISC + 8);
    int ph = 0;
#define RUN (relaunder(F), ({ asm volatile("" : "+s"(p)); 0; }), lo <= ph && ph < hi)
#define SEAM do { if (lo <= ph && ph + 1 < hi) { relaunder(F); xcd_barrier(bar, F.tid == 0); } ++ph; } while (0)
#define WSP(T, off) ((T*)(p->ws + (off)))
    if (RUN) p0_prologue(F, p);
    SEAM;
    for (int hl = 0; hl < 2 * NLAYER; ++hl) {
        const int l = hl >> 1, f = hl & 1;
#define MODL ((const float*)(p->ws + WS_MOD) + (size_t)l * NB * NMOD)
#define WL(off) ((const bf16*)(p->ws + WS_W + (size_t)l * LW_BYTES + (off)))
        if (f) {
            if (RUN) norm_phase(F, p->out, p->in[I_GMIX] + l * DM, MODL, 3, 4, WSP(bf16, WS_H));
            SEAM;
            if (RUN) { pg8::Gemm g{WSP(bf16, WS_H), WL(LW_IN), M, NP, DM, DM, DM}; pg8::StaticOrder S; S.init(M, NP, F.G, (int)blockIdx.x); pg8::EpiBf16 E{WSP(bf16, WS_P), NP};
                pg8::gemm_phase<pg8::EpiBf16, pg8::StaticOrder, true, true>(F.lds, g, S, E, F.wave); }
            SEAM;
            if (RUN) { post1_phase(F, p, l); indexer_phase(F, p, 1 + 2 * l); }
            SEAM;
            if (RUN) {
                { pg8::Gemm g{WSP(bf16, WS_P) + PC_CQ, WL(LW_UQ), M, NQB, 512, NP, 512}; pg8::StaticOrder S; S.init(M, NQB, F.G, (int)blockIdx.x); pg8::EpiBf16 E{WSP(bf16, WS_QB), NQB};
                  pg8::gemm_phase<pg8::EpiBf16, pg8::StaticOrder, true, true>(F.lds, g, S, E, F.wave); }
                relaunder(F); asm volatile("" : "+s"(p));
                { pg8::Gemm g{WSP(bf16, WS_P) + PC_CKV, WL(LW_UKV), M, NKVB, 128, NP, 128}; pg8::StaticOrder S; S.init(M, NKVB, F.G, (int)blockIdx.x); pg8::EpiKV E{WSP(bf16, WS_KVB), p->in[I_GKN] + l * 128, (LAS float*)(F.lds + RING_BYTES + 4096), NKVB};
                  pg8::gemm_phase<pg8::EpiKV, pg8::StaticOrder, true, true>(F.lds, g, S, E, F.wave); }
            }
            SEAM;
            if (RUN) attn_phase_all(F, p, 2 + 2 * l, l);
            SEAM;
            if (RUN) { pg8::Gemm g{WSP(bf16, WS_H), WL(LW_OUT), M, DM, DM, DM, DM}; pg8::StaticOrder S; S.init(M, DM, F.G, (int)blockIdx.x, WGM_RESID); pg8::EpiResid E{p->out, p->out, MODL + 5 * DM, 1.0f};
                pg8::gemm_phase<pg8::EpiResid, pg8::StaticOrder, true, true>(F.lds, g, S, E, F.wave); }
            SEAM;
        }
#define XIN ((hl == 0) ? p->in[I_X] : (const float*)p->out)
        if (RUN) norm_phase(F, XIN, p->in[f ? I_GFFN2 : I_GFFN1] + l * DM, MODL, f ? 6 : 0, f ? 7 : 1, WSP(bf16, WS_H));
        SEAM;
        for (int mh = 0; mh < FFN_SPLIT; ++mh) {
            constexpr int MS = M / FFN_SPLIT; const size_t r0 = (size_t)mh * MS;
            if (RUN) { pg8::Gemm g{WSP(bf16, WS_H) + r0 * DM, WL(f ? LW_GU2 : LW_GU1), MS, 2 * FF, DM, DM, DM}; pg8::StaticOrder S; S.init(MS, 2 * FF, F.G, (int)blockIdx.x); pg8::EpiSwiGLU E{WSP(bf16, WS_HID), FF};
                pg8::gemm_phase<pg8::EpiSwiGLU, pg8::StaticOrder, true, true>(F.lds, g, S, E, F.wave); }
            SEAM;
            if (RUN) { pg8::Gemm g{WSP(bf16, WS_HID), WL(f ? LW_DN2 : LW_DN1), MS, DM, FF, FF, FF}; pg8::StaticOrder S; S.init(MS, DM, F.G, (int)blockIdx.x, WGM_RESID, 1);
                pg8::EpiResid E{XIN + r0 * DM, p->out + r0 * DM, MODL + (f ? 8 : 2) * DM + (r0 / SEQ) * NMOD, 0.5f};
                pg8::gemm_phase<pg8::EpiResid, pg8::StaticOrder, true, true>(F.lds, g, S, E, F.wave); }
            SEAM;
        }
    }
#undef RUN
#undef SEAM
}

extern "C" void kernel_launch(void* const* d_in, const int* in_sizes, int n_in, void* d_out, int out_size, void* d_ws, size_t ws_size, hipStream_t stream) {
    static int grid = 0;
    if (grid == 0) {
        if (n_in != 25 || in_sizes[0] != M * DM || out_size != M * DM || ws_size < WS_END) { fprintf(stderr, "kernel_launch: shape mismatch: n_in %d in0 %d out %d ws %zu (need %zu)\n", n_in, n_in > 0 ? in_sizes[0] : -1, out_size, ws_size, (size_t)WS_END); grid = -1; return; }
        int dev = 0, cus = 0, per_cu = 0;
        if (hipGetDevice(&dev) != hipSuccess || hipDeviceGetAttribute(&cus, hipDeviceAttributeMultiprocessorCount, dev) != hipSuccess) { grid = -1; return; }
        if (hipFuncSetAttribute((const void*)mega_fwd, hipFuncAttributeMaxDynamicSharedMemorySize, LDS_BYTES) != hipSuccess) { fprintf(stderr, "kernel_launch: hipFuncSetAttribute failed\n"); grid = -1; return; }
        if (hipOccupancyMaxActiveBlocksPerMultiprocessor(&per_cu, (const void*)mega_fwd, NWAVES * 64, LDS_BYTES) != hipSuccess || per_cu < 1) fprintf(stderr, "kernel_launch: occupancy query reports %d blocks per CU\n", per_cu);
        (void)hipGetLastError();
        grid = cus;
    }
    if (grid < 0) return;
    if (hipMemsetAsync((char*)d_ws + WS_CTL, 0, CTL_ZERO_BYTES, stream) != hipSuccess) return;
    Params a{};
    for (int i = 0; i < 25; ++i) a.in[i] = (const float*)d_in[i];
    a.out = (float*)d_out; a.ws = (unsigned char*)d_ws;
    const int nph = N_PHASES < PH_STOP ? N_PHASES : PH_STOP;
#if MK_N_LAUNCHES == 1
    a.ph_lo = 0; a.ph_hi = nph;
    hipLaunchKernelGGL(mega_fwd, dim3(grid), dim3(NWAVES * 64), LDS_BYTES, stream, a);
#else
    for (int k = 0; k < nph; ++k) { a.ph_lo = k; a.ph_hi = k + 1; hipLaunchKernelGGL(mega_fwd, dim3(grid), dim3(NWAVES * 64), LDS_BYTES, stream, a); }
#endif
    const hipError_t le = hipPeekAtLastError();
    if (le != hipSuccess) fprintf(stderr, "kernel_launch: launch failed: %s\n", hipGetErrorName(le));
}
```

```cpp
#include <hip/hip_runtime.h>
#include <cstdio>
#include <cstdint>

#ifndef MK_N_LAUNCHES
#define MK_N_LAUNCHES 1
#endif
#ifndef PH_STOP
#define PH_STOP 1000
#endif

#define GAS __attribute__((address_space(1)))
#define LAS __attribute__((address_space(3)))
typedef unsigned short bf16;
typedef unsigned v4u __attribute__((ext_vector_type(4)));
typedef unsigned v2u __attribute__((ext_vector_type(2)));
typedef float f32x4 __attribute__((ext_vector_type(4)));
typedef float f32x2 __attribute__((ext_vector_type(2)));
typedef float f32x16 __attribute__((ext_vector_type(16)));
typedef short bf16x8 __attribute__((ext_vector_type(8)));
typedef short s16x4 __attribute__((ext_vector_type(4)));
typedef GAS unsigned gu32;
#define RLX_AGENT __ATOMIC_RELAXED, __HIP_MEMORY_SCOPE_AGENT
#define LDS_WAIT() asm volatile("s_waitcnt lgkmcnt(0)" ::: "memory")
#define VM_WAIT() asm volatile("s_waitcnt vmcnt(0)" ::: "memory")
#define SBAR() __builtin_amdgcn_sched_barrier(0)
__device__ __forceinline__ unsigned cvt_pk_bf16(float lo, float hi) { unsigned r; asm volatile("v_cvt_pk_bf16_f32 %0, %1, %2" : "=v"(r) : "v"(lo), "v"(hi)); return r; }
__device__ __forceinline__ int lane_id_fresh() { int l; asm volatile("v_mbcnt_lo_u32_b32 %0, -1, 0\n\tv_mbcnt_hi_u32_b32 %0, -1, %0" : "=v"(l)); return l; }
__device__ __forceinline__ unsigned cvt_pk_bf16_nv(float lo, float hi) { unsigned r; asm("v_cvt_pk_bf16_f32 %0, %1, %2" : "=v"(r) : "v"(lo), "v"(hi)); return r; }
__device__ __forceinline__ float bf_lo(unsigned w) { return __uint_as_float(w << 16); }
__device__ __forceinline__ float bf_hi(unsigned w) { return __uint_as_float(w & 0xffff0000u); }

constexpr int NB = 8, SEQ = 4096, DM = 2048, M = NB * SEQ, FF = 5632, NLAYER = 2, NMOD = 9 * DM;
constexpr int NIN = 4816, NP = 5120;
constexpr int PC_QA = 0, PC_KA = 512, PC_VA = 1024, PC_QI = 1536, PC_KI = 2560, PC_WI = 2624, PC_CQ = 2688, PC_CKV = 3200, PC_KR = 3328, PC_QC = 3584, PC_KC = 4096, PC_VC = 4608;
constexpr int NQB = 1536, NKVB = 2048;
constexpr float NORM_EPS = 1e-6f;

namespace pg8 {
#define PG8_LAS __attribute__((address_space(3)))
typedef unsigned short bf16_t;
constexpr int BM = 256, BK = 64, HALF = 128, HTB = HALF * BK * 2  , STAGE_BYTES = 8 * HTB, NXCD = 8, WGM = 4;
__host__ __device__ __forceinline__ int lds_byte(int r, int c) { const int st = (r >> 4) * 2 + (c >> 5), rr = r & 15, cc = c & 31, ob = rr * 64 + cc * 2; return st * 1024 + (ob ^ (((ob >> 9) & 1) << 5)); }
__host__ __device__ __forceinline__ void stage_rc(int b, int& R, int& C) { const int st = b / 1024, sb = b % 1024, swz = sb ^ (((sb >> 9) & 1) << 5); R = (st >> 1) * 16 + swz / 64; C = (st & 1) * 32 + (swz % 64) / 2; }
__host__ __device__ __forceinline__ int perm32(int rho) { const int n = rho >> 4, i = rho & 15; return 8 * (i >> 2) + 4 * n + (i & 3); }
struct Unit { int pm, pn; };
struct Gemm { const bf16_t* A; const bf16_t* Bt; int M, N, K, lda, ldb; };
struct StaticOrder {
    int nM, nN, nwg, G, c, wgm, rev;
    __host__ __device__ void init(int M_, int N_, int G_, int c_, int wgm_ = WGM, int rev_ = 0) { nM = M_ / BM; nN = N_ / BM; nwg = nM * nN; G = G_; c = c_; wgm = wgm_; rev = rev_; }
    __host__ __device__ bool next(int i, Unit& u) const {
        const long L = (long)i * G + c; if (L >= nwg) return false;
        int wgid = (int)L; { const int q = nwg / NXCD, r = nwg % NXCD, xcd = wgid % NXCD, off = wgid / NXCD; wgid = (xcd < r ? xcd * (q + 1) : r * (q + 1) + (xcd - r) * q) + off; }
        const int nig = wgm * nN, gid = wgid / nig, fm = gid * wgm, gsz = (nM - fm) < wgm ? (nM - fm) : wgm;
        u.pm = fm + ((wgid % nig) % gsz); u.pn = (wgid % nig) / gsz; if (rev) u.pm = nM - 1 - u.pm; return true;
    }
};
struct EpiBf16 {
    static constexpr bool PERM = true;
    bf16_t* O; int ldc;
    __device__ __forceinline__ void operator()(const f32x4 (&acc)[2][2][4][2], const Unit& u, int wr, int wc, int fr, int fq) const {
        const int row0 = u.pm * BM + wr * 64 + fr, col0 = u.pn * BM + wc * 32 + 8 * fq;
#pragma unroll
        for (int ai = 0; ai < 2; ++ai)
#pragma unroll
            for (int m = 0; m < 4; ++m) { bf16_t* rowp = O + (size_t)(row0 + ai * HALF + m * 16) * ldc + col0;
#pragma unroll
                for (int bj = 0; bj < 2; ++bj) { const f32x4 v0 = acc[ai][bj][m][0], v1 = acc[ai][bj][m][1];
                    v4u w; w.x = cvt_pk_bf16(v0[0], v0[1]); w.y = cvt_pk_bf16(v0[2], v0[3]); w.z = cvt_pk_bf16(v1[0], v1[1]); w.w = cvt_pk_bf16(v1[2], v1[3]);
                    *(v4u*)(rowp + bj * HALF) = w; } }
    }
};
struct EpiKV {
    static constexpr bool PERM = true;
    bf16_t* O; const float* gk; PG8_LAS float* part; int ldc;
    __device__ __forceinline__ void operator()(const f32x4 (&acc)[2][2][4][2], const Unit& u, int wr, int wc, int fr, int fq) const {
        const int row0 = u.pm * BM + wr * 64 + fr, col0 = u.pn * BM + wc * 32 + 8 * fq;
#pragma unroll
        for (int ai = 0; ai < 2; ++ai)
#pragma unroll
            for (int m = 0; m < 4; ++m) { const f32x4 v0 = acc[ai][0][m][0], v1 = acc[ai][0][m][1];
                float s = ((v0[0] * v0[0] + v0[1] * v0[1]) + (v0[2] * v0[2] + v0[3] * v0[3])) + ((v1[0] * v1[0] + v1[1] * v1[1]) + (v1[2] * v1[2] + v1[3] * v1[3]));
                { auto r = __builtin_amdgcn_permlane16_swap(__float_as_uint(s), __float_as_uint(s), false, false); s = __uint_as_float(r[0]) + __uint_as_float(r[1]); }
                { auto r = __builtin_amdgcn_permlane32_swap(__float_as_uint(s), __float_as_uint(s), false, false); s = __uint_as_float(r[0]) + __uint_as_float(r[1]); }
                if (fq == 0) part[(wr * 128 + ai * 64 + m * 16 + fr) * 4 + wc] = s; }
        asm volatile("s_waitcnt lgkmcnt(0)" ::: "memory"); __builtin_amdgcn_s_barrier(); asm volatile("" ::: "memory");
        const f32x4 g0 = *(const f32x4*)(gk + wc * 32 + 8 * fq), g1 = *(const f32x4*)(gk + wc * 32 + 8 * fq + 4);
#pragma unroll
        for (int ai = 0; ai < 2; ++ai)
#pragma unroll
            for (int m = 0; m < 4; ++m) { bf16_t* rowp = O + (size_t)(row0 + ai * HALF + m * 16) * ldc + col0;
                const f32x4 q = *(const PG8_LAS f32x4*)(part + (wr * 128 + ai * 64 + m * 16 + fr) * 4);
                const float rstd = rsqrtf(((q[0] + q[1]) + (q[2] + q[3])) * (1.0f / 128) + NORM_EPS);
                const f32x4 v0 = acc[ai][0][m][0], v1 = acc[ai][0][m][1];
                v4u w; w.x = cvt_pk_bf16(v0[0] * rstd * g0[0], v0[1] * rstd * g0[1]); w.y = cvt_pk_bf16(v0[2] * rstd * g0[2], v0[3] * rstd * g0[3]);
                w.z = cvt_pk_bf16(v1[0] * rstd * g1[0], v1[1] * rstd * g1[1]); w.w = cvt_pk_bf16(v1[2] * rstd * g1[2], v1[3] * rstd * g1[3]);
                *(v4u*)rowp = w;
                const f32x4 x0 = acc[ai][1][m][0], x1 = acc[ai][1][m][1];
                v4u z; z.x = cvt_pk_bf16(x0[0], x0[1]); z.y = cvt_pk_bf16(x0[2], x0[3]); z.z = cvt_pk_bf16(x1[0], x1[1]); z.w = cvt_pk_bf16(x1[2], x1[3]);
                *(v4u*)(rowp + HALF) = z; }
    }
};
__device__ __forceinline__ void silu_mul4(const f32x4 g, const f32x4 u, unsigned& o0, unsigned& o1) {
    float t0, t1, t2, t3;
    asm volatile(
        "v_exp_f32_e32 %0, %4\n\tv_exp_f32_e32 %1, %5\n\tv_exp_f32_e32 %2, %6\n\tv_exp_f32_e32 %3, %7\n\t"
        "v_add_f32_e32 %0, 1.0, %0\n\tv_add_f32_e32 %1, 1.0, %1\n\tv_add_f32_e32 %2, 1.0, %2\n\tv_add_f32_e32 %3, 1.0, %3\n\t"
        "v_rcp_f32_e32 %0, %0\n\tv_rcp_f32_e32 %1, %1\n\tv_rcp_f32_e32 %2, %2\n\tv_rcp_f32_e32 %3, %3\n\t"
        "v_mul_f32_e32 %0, %4, %0\n\tv_mul_f32_e32 %1, %5, %1\n\tv_mul_f32_e32 %2, %6, %2\n\tv_mul_f32_e32 %3, %7, %3\n\t"
        "v_mul_f32_e32 %0, %8, %0\n\tv_mul_f32_e32 %1, %9, %1\n\tv_mul_f32_e32 %2, %10, %2\n\tv_mul_f32_e32 %3, %11, %3\n\t"
        "v_cvt_pk_bf16_f32 %0, %0, %1\n\tv_cvt_pk_bf16_f32 %2, %2, %3"
        : "=&v"(t0), "=&v"(t1), "=&v"(t2), "=&v"(t3)
        : "v"(g[0]), "v"(g[1]), "v"(g[2]), "v"(g[3]), "v"(u[0]), "v"(u[1]), "v"(u[2]), "v"(u[3]));
    o0 = __float_as_uint(t0); o1 = __float_as_uint(t2);
}
struct EpiSwiGLU {
    static constexpr bool PERM = true;
    bf16_t* O; int ldc;
    __device__ __forceinline__ void operator()(const f32x4 (&acc)[2][2][4][2], const Unit& u, int wr, int wc, int fr, int fq) const {
        const int row0 = u.pm * BM + wr * 64 + fr, col0 = u.pn * HALF + wc * 32 + 8 * fq;
#pragma unroll
        for (int ai = 0; ai < 2; ++ai)
#pragma unroll
            for (int m = 0; m < 4; ++m) { bf16_t* rowp = O + (size_t)(row0 + ai * HALF + m * 16) * ldc + col0;
                unsigned w0, w1, w2, w3; silu_mul4(acc[ai][0][m][0], acc[ai][1][m][0], w0, w1); silu_mul4(acc[ai][0][m][1], acc[ai][1][m][1], w2, w3);
                v4u w; w.x = w0; w.y = w1; w.z = w2; w.w = w3;
                *(v4u*)rowp = w; }
    }
};
struct EpiResid {
    static constexpr bool PERM = false;
    const float* base; float* out; const float* gate; float s;
    __device__ __forceinline__ void operator()(const f32x4 (&acc)[2][2][4][2], const Unit& u, int wr, int wc, int fr, int fq) const {
        const int row0 = u.pm * BM + wr * 64 + fr, col0 = u.pn * BM + wc * 32 + 4 * fq;
        const float* gp = gate + (size_t)((u.pm * BM) / SEQ) * NMOD + col0;
        f32x4 gv[2][2];
#pragma unroll
        for (int bj = 0; bj < 2; ++bj)
#pragma unroll
            for (int n = 0; n < 2; ++n) { const f32x4 g = *(const f32x4*)(gp + bj * HALF + n * 16); gv[bj][n] = (g + 1.0f) * s; }
#define ER_OFF(e) ((size_t)(row0 + ((e) >> 4) * HALF + (((e) >> 2) & 3) * 16) * DM + col0 + (((e) >> 1) & 1) * HALF + ((e) & 1) * 16)
        f32x4 bs[16];
#pragma unroll
        for (int e = 0; e < 16; ++e) bs[e] = *(const f32x4*)(base + ER_OFF(e));
#pragma unroll
        for (int e = 0; e < 32; ++e) {
            const f32x4 v = bs[e & 15] + gv[(e >> 1) & 1][e & 1] * acc[e >> 4][(e >> 1) & 1][(e >> 2) & 3][e & 1];
            *(f32x4*)(out + ER_OFF(e)) = v;
            if (e + 16 < 32) bs[e & 15] = *(const f32x4*)(base + ER_OFF(e + 16));
        }
#undef ER_OFF
    }
};
template <class Epi, class Sched, bool ALIGN_EPI = false, bool SP2 = false>
__device__ __forceinline__ void gemm_phase(PG8_LAS unsigned char* lds, const Gemm g, const Sched& S, const Epi& E, int wv) {
    int wid_ = wv; asm volatile("" : "+s"(wid_));
    const int wid = wid_, lane = lane_id_fresh(), tid = (wid << 6) | lane, wr = wid >> 2, wc = wid & 3, fr = lane & 15, fq = lane >> 4;
    int K = g.K; asm volatile("" : "+s"(K)); const int nt = K / BK;
    unsigned voffA[2], voffB[2];
#pragma unroll
    for (int i = 0; i < 2; ++i) { int R, C; stage_rc(tid * 16 + i * 8192, R, C); const int Rb = Epi::PERM ? ((R & ~31) + perm32(R & 31)) : R;
        voffA[i] = (unsigned)(R * g.lda + C) * 2u; voffB[i] = (unsigned)(Rb * g.ldb + C) * 2u; }
    const size_t kstep = (size_t)(BK * 2);
    const size_t hstepA = (size_t)HALF * g.lda * 2, hstepB = (size_t)HALF * g.ldb * 2;
    const size_t tstepA = 2 * hstepA, tstepB = 2 * hstepB;
    const unsigned ldsw = (unsigned)wid * 1024u;
    const int aoff = lds_byte(wr * 64 + fr, fq * 8), boff = lds_byte(wc * 32 + fr, fq * 8);
#define PG8_SA(b, h) (((b) * 2 + (h)) * HTB)
#define PG8_SB(b, h) ((4 + (b) * 2 + (h)) * HTB)
#define PG8_STAGE(bufoff, gbase, voff) do { const char* _gb = (const char*)(gbase); asm volatile("" : "+s"(_gb));   \
        _Pragma("unroll") for (int _i = 0; _i < 2; ++_i) __builtin_amdgcn_global_load_lds((const unsigned*)(_gb + (voff)[_i]), (PG8_LAS unsigned*)(lds + (bufoff) + ldsw + _i * 8192), 16, 0, 0); } while (0)
#define PG8_VOFF_FRESH asm volatile("" : "+v"(voffA[0]), "+v"(voffA[1]), "+v"(voffB[0]), "+v"(voffB[1]))
#define PG8_LDA(dst, b, h) do { _Pragma("unroll") for (int m = 0; m < 4; ++m) _Pragma("unroll") for (int k = 0; k < 2; ++k) dst[m][k] = *(const PG8_LAS bf16x8*)(lds + PG8_SA(b, h) + aoff + m * 2048 + k * 1024); } while (0)
#define PG8_LDB(dst, b, h) do { _Pragma("unroll") for (int n = 0; n < 2; ++n) _Pragma("unroll") for (int k = 0; k < 2; ++k) dst[n][k] = *(const PG8_LAS bf16x8*)(lds + PG8_SB(b, h) + boff + n * 2048 + k * 1024); } while (0)
#define PG8_MFMA(m, n, k, C) __builtin_amdgcn_mfma_f32_16x16x32_bf16(Bt_[n][k], At_[m][k], C, 0, 0, 0)
#define PG8_MMA(ai, bj, At, Bt, FIRST) do { auto& At_ = At; auto& Bt_ = Bt; __builtin_amdgcn_s_setprio(1); \
        if (FIRST) { _Pragma("unroll") for (int m = 0; m < 4; ++m) _Pragma("unroll") for (int n = 0; n < 2; ++n) acc[ai][bj][m][n] = PG8_MFMA(m, n, 0, ((f32x4){0.f, 0.f, 0.f, 0.f})); } \
        else       { _Pragma("unroll") for (int m = 0; m < 4; ++m) _Pragma("unroll") for (int n = 0; n < 2; ++n) acc[ai][bj][m][n] = PG8_MFMA(m, n, 0, acc[ai][bj][m][n]); } \
        _Pragma("unroll") for (int m = 0; m < 4; ++m) _Pragma("unroll") for (int n = 0; n < 2; ++n) acc[ai][bj][m][n] = PG8_MFMA(m, n, 1, acc[ai][bj][m][n]); \
        __builtin_amdgcn_s_setprio(0); } while (0)
#define PG8_WAIT_V(n) asm volatile("s_waitcnt vmcnt(" #n ")" ::: "memory")
#define PG8_WAIT_L(n) asm volatile("s_waitcnt lgkmcnt(" #n ")" ::: "memory")
#define PG8_BAR __builtin_amdgcn_s_barrier()
#define PG8_SCHED __builtin_amdgcn_sched_barrier(0)
    Unit cur, nxt; int ui = 0;
    if (!S.next(0, cur)) return;
    static_assert(SP2, "only the two-super-phase K-loop is kept");
    f32x4 acc[2][2][4][2];
    bf16x8 At[4][2], B0[2][2], B1[2][2];
    const char* cA = (const char*)g.A + (size_t)cur.pm * tstepA; const char* cB = (const char*)g.Bt + (size_t)cur.pn * tstepB;
    PG8_VOFF_FRESH;
    if constexpr (SP2) {
        PG8_STAGE(PG8_SB(0, 0), cB, voffB); PG8_STAGE(PG8_SB(0, 1), cB + hstepB, voffB); PG8_STAGE(PG8_SA(0, 0), cA, voffA); PG8_STAGE(PG8_SA(0, 1), cA + hstepA, voffA);
        if (wr == 1) PG8_BAR;
        PG8_WAIT_V(2); PG8_BAR;
        PG8_STAGE(PG8_SB(1, 0), cB + kstep, voffB); PG8_STAGE(PG8_SA(1, 0), cA + kstep, voffA); PG8_STAGE(PG8_SB(1, 1), cB + hstepB + kstep, voffB);
        PG8_WAIT_V(6); PG8_BAR;
    } else {
        PG8_STAGE(PG8_SB(0, 0), cB, voffB); PG8_STAGE(PG8_SA(0, 0), cA, voffA); PG8_STAGE(PG8_SB(0, 1), cB + hstepB, voffB); PG8_STAGE(PG8_SA(0, 1), cA + hstepA, voffA);
        if (wr == 1) PG8_BAR;
        PG8_WAIT_V(4); PG8_BAR;
        PG8_STAGE(PG8_SB(1, 0), cB + kstep, voffB); PG8_STAGE(PG8_SA(1, 0), cA + kstep, voffA); PG8_STAGE(PG8_SB(1, 1), cB + hstepB + kstep, voffB);
        PG8_WAIT_V(6); PG8_BAR;
    }
    for (;;) {
        const bool has_next = S.next(ui + 1, nxt);
        const char* nA = has_next ? (const char*)g.A + (size_t)nxt.pm * tstepA : cA; const char* nB = has_next ? (const char*)g.Bt + (size_t)nxt.pn * tstepB : cB;
#define PG8_KT2(t, FIRST) do { \
            const bool last = ((t) == nt - 2); \
            const char* a1 = cA + (size_t)((t) + 1) * kstep; \
            const char* a2 = last ? nA : cA + (size_t)((t) + 2) * kstep; const char* b2 = last ? nB : cB + (size_t)((t) + 2) * kstep; \
            const char* a3 = a2 + kstep; const char* b3 = b2 + kstep; PG8_VOFF_FRESH; \
            PG8_LDB(B0, 0, 0); PG8_LDB(B1, 0, 1); PG8_SCHED; PG8_LDA(At, 0, 0); PG8_STAGE(PG8_SA(1, 1), a1 + hstepA, voffA); \
            PG8_WAIT_V(8); PG8_WAIT_L(0); PG8_BAR; PG8_MMA(0, 0, At, B0, FIRST); PG8_MMA(0, 1, At, B1, FIRST); PG8_BAR; PG8_SCHED; \
            PG8_LDA(At, 0, 1); PG8_STAGE(PG8_SB(0, 0), b2, voffB); PG8_STAGE(PG8_SB(0, 1), b2 + hstepB, voffB); PG8_STAGE(PG8_SA(0, 0), a2, voffA); \
            PG8_WAIT_V(8); PG8_WAIT_L(0); PG8_BAR; PG8_MMA(1, 0, At, B0, FIRST); PG8_MMA(1, 1, At, B1, FIRST); PG8_BAR; PG8_SCHED; \
            PG8_LDB(B0, 1, 0); PG8_LDB(B1, 1, 1); PG8_SCHED; PG8_LDA(At, 1, 0); PG8_STAGE(PG8_SA(0, 1), a2 + hstepA, voffA); \
            PG8_WAIT_V(8); PG8_WAIT_L(0); PG8_BAR; PG8_MMA(0, 0, At, B0, false); PG8_MMA(0, 1, At, B1, false); PG8_BAR; PG8_SCHED; \
            PG8_LDA(At, 1, 1); PG8_STAGE(PG8_SB(1, 0), b3, voffB); PG8_STAGE(PG8_SB(1, 1), b3 + hstepB, voffB); PG8_STAGE(PG8_SA(1, 0), a3, voffA); \
            PG8_WAIT_V(8); PG8_WAIT_L(0); PG8_BAR; PG8_MMA(1, 0, At, B0, false); PG8_MMA(1, 1, At, B1, false); PG8_BAR; PG8_SCHED; \
        } while (0)
        for (int t = 0; t < nt; t += 2) { const bool first = (t == 0); PG8_KT2(t, first); }
#undef PG8_KT2
        if constexpr (ALIGN_EPI) { if (wr == 0) PG8_BAR; }
        { const int le = lane_id_fresh(); E(acc, cur, wr, wc, le & 15, le >> 4); }
        if (!has_next) break;
        cur = nxt; cA = nA; cB = nB; ++ui;
        if constexpr (ALIGN_EPI) { if (wr == 1) PG8_BAR; }
    }
    PG8_WAIT_V(0);
    if constexpr (!ALIGN_EPI) { if (wr == 0) PG8_BAR; }
    PG8_BAR;
#undef PG8_SA
#undef PG8_SB
#undef PG8_STAGE
#undef PG8_VOFF_FRESH
#undef PG8_LDA
#undef PG8_LDB
#undef PG8_MMA
#undef PG8_WAIT_V
#undef PG8_WAIT_L
#undef PG8_BAR
#undef PG8_SCHED
}
}

constexpr size_t MiB = 1u << 20;
constexpr size_t WS_CTL = 0, CTL_ZERO_BYTES = 1 * MiB;
constexpr size_t WS_MOD = 1 * MiB;
constexpr size_t WS_TAB = 3 * MiB;
constexpr size_t WS_W = 5 * MiB;
constexpr size_t W_GU = (size_t)2 * FF * DM * 2, W_DN = (size_t)DM * FF * 2, W_IN = (size_t)NP * DM * 2, W_UQ = (size_t)NQB * 512 * 2, W_UKV = (size_t)NKVB * 128 * 2, W_OUT = (size_t)DM * DM * 2;
constexpr size_t LW_GU1 = 0, LW_DN1 = LW_GU1 + W_GU, LW_GU2 = LW_DN1 + W_DN, LW_DN2 = LW_GU2 + W_GU, LW_IN = LW_DN2 + W_DN, LW_UQ = LW_IN + W_IN, LW_UKV = LW_UQ + W_UQ, LW_OUT = LW_UKV + W_UKV, LW_BYTES = LW_OUT + W_OUT;
constexpr size_t WS_H = WS_W + NLAYER * LW_BYTES;
constexpr size_t WS_SCR = WS_H + (size_t)M * DM * 2;
constexpr size_t WS_HID = WS_SCR;
constexpr size_t WS_P = WS_SCR, WS_QB = WS_P + (size_t)M * NP * 2, WS_KVB = WS_QB + (size_t)M * NQB * 2, WS_MASK = WS_KVB + (size_t)M * NKVB * 2, WS_KI = WS_MASK + (size_t)M * 128 * 4, WS_MIXEND = WS_KI + (size_t)M * 64 * 2;
constexpr size_t WS_END = (WS_MIXEND > WS_HID + (size_t)M * FF * 2) ? WS_MIXEND : WS_HID + (size_t)M * FF * 2;
static_assert(LW_BYTES % 256 == 0 && WS_H % 256 == 0 && WS_SCR % 256 == 0, "alignment");
constexpr int CW_BAR = 4096;
constexpr int CW_QUEUE = 16384;

constexpr int RING_BYTES = 131072;
constexpr int LDSCTL_OFF = RING_BYTES, MISC_OFF = LDSCTL_OFF + 320;
constexpr int LDS_BYTES = 147456;
constexpr int NWAVES = 8;

#define XB_TMO      128
#define XB_XCNT(j)  (256  + 64 * (j))
#define XB_XSUB(j)  (1280 + 64 * (j))
#define XB_XGEN(j)  (2304 + 64 * (j))
#define XB_TOP      3328
#define XB_TOPGEN   3392
#define XCD_BAR_WORDS 3456
#define XB_SPIN_CAP (1u << 18)

__device__ __forceinline__ unsigned xb_ld(unsigned* p)              { return __hip_atomic_load(p, __ATOMIC_RELAXED, __HIP_MEMORY_SCOPE_AGENT); }
__device__ __forceinline__ unsigned xb_add(unsigned* p, unsigned v) { return __hip_atomic_fetch_add(p, v, __ATOMIC_RELAXED, __HIP_MEMORY_SCOPE_AGENT); }
__device__ __forceinline__ unsigned xb_xcc_id() { return (unsigned)__builtin_amdgcn_s_getreg((3 << 11) | 20) & 0xFu; }
#define XB_SPIN(cond, bar) do { unsigned _sp = 0; while (cond) { __builtin_amdgcn_s_sleep(1); \
    if ((++_sp & 255u) == 0u) { if (xb_ld(&(bar)[XB_TMO])) break; if (_sp > XB_SPIN_CAP) { atomicAdd(&(bar)[XB_TMO], 1u); break; } } } } while (0)

struct XcdBarrier {
    unsigned* bar; unsigned x;
    volatile LAS unsigned* st;
};

__device__ __forceinline__ XcdBarrier xcd_barrier_post(unsigned* bar, volatile LAS unsigned* st) {
    XcdBarrier b; b.bar = bar; b.x = xb_xcc_id(); b.st = st;
    if (threadIdx.x == 0) (void)xb_add(&bar[XB_XCNT(b.x)], 1u);
    return b;
}
__device__ __forceinline__ void xcd_barrier_complete(unsigned* bar, unsigned x, unsigned& nloc, unsigned& nx) {
    const unsigned G = gridDim.x * gridDim.y * gridDim.z;
    unsigned sum, cnt, mine, sp = 0u;
    for (;;) {
        sum = 0u; cnt = 0u; mine = 0u;
#pragma unroll
        for (unsigned j = 0; j < 16; ++j) { const unsigned c = xb_ld(&bar[XB_XCNT(j)]); sum += c; cnt += (c > 0u) ? 1u : 0u; mine = (j == x) ? c : mine; }
        if (sum == G) break;
        __builtin_amdgcn_s_sleep(1);
        if ((++sp & 255u) == 0u) { if (xb_ld(&bar[XB_TMO])) break; if (sp > XB_SPIN_CAP) { atomicAdd(&bar[XB_TMO], 1u); break; } }
    }
    nloc = mine > 0u ? mine : 1u; nx = cnt > 0u ? cnt : 1u;
}

__device__ __forceinline__ void xcd_barrier(const XcdBarrier& b, const bool t0) {
    asm volatile("s_waitcnt vmcnt(0)" ::: "memory");
    __syncthreads();
    if (t0) {
        unsigned* bar = b.bar;
        __builtin_amdgcn_s_waitcnt(0);
        unsigned nloc = b.st[0], nx = b.st[1];
        if (nloc == 0u) { xcd_barrier_complete(bar, b.x, nloc, nx); b.st[0] = nloc; b.st[1] = nx; }
        const unsigned old = xb_add(&bar[XB_XSUB(b.x)], 1u);
        const unsigned gen = old / nloc;
        if (old + 1u == (gen + 1u) * nloc) {
            __builtin_amdgcn_fence(__ATOMIC_RELEASE, "agent");
            asm volatile("s_waitcnt vmcnt(0)" ::: "memory");
            const unsigned og = xb_add(&bar[XB_TOP], 1u);
            const unsigned tg = og / nx;
            if (og + 1u == (tg + 1u) * nx) xb_add(&bar[XB_TOPGEN], 1u);
            else XB_SPIN(xb_ld(&bar[XB_TOPGEN]) == tg, bar);
            __builtin_amdgcn_fence(__ATOMIC_ACQUIRE, "agent");
            xb_add(&bar[XB_XGEN(b.x)], 1u);
            asm volatile("s_waitcnt vmcnt(0)" ::: "memory");
        } else {
            XB_SPIN(xb_ld(&bar[XB_XGEN(b.x)]) == gen, bar);
            __builtin_amdgcn_fence(__ATOMIC_ACQUIRE, "agent");
            asm volatile("s_waitcnt vmcnt(0)" ::: "memory");
        }
    }
    __syncthreads();
}

struct Params { const float* in[25]; float* out; unsigned char* ws; int ph_lo, ph_hi; };
typedef const __attribute__((address_space(4))) Params* KParams;
enum { I_X = 0, I_C, I_WADA, I_BADA, I_GFFN1, I_W1G, I_W1U, I_W1D, I_GMIX, I_WIN, I_GQA, I_GKA, I_GCQ, I_GCKV, I_WUQ, I_WUKV, I_GQN, I_GKN, I_GQR, I_GKR, I_WOUT, I_GFFN2, I_W2G, I_W2U, I_W2D };
struct Frame {
    LAS unsigned char* lds; volatile LAS unsigned* MISC; gu32* ctl;
    int tid, lane, wave, vcu, G, wave0;
};
__device__ __forceinline__ void relaunder(Frame& F) { int w = F.wave0; asm volatile("" : "+s"(w)); const int l = lane_id_fresh(); F.wave = w; F.lane = l; F.tid = (w << 6) | l; }
#define XS_DPP(x, ctrl) __builtin_amdgcn_update_dpp(0, (x), (ctrl), 0xF, 0xF, true)
template <int W> __device__ __forceinline__ float xsum(float v) {
    if constexpr (W > 1) v += __int_as_float(XS_DPP(__float_as_int(v), 0xB1));
    if constexpr (W > 2) v += __int_as_float(XS_DPP(__float_as_int(v), 0x4E));
    if constexpr (W > 4) v += __int_as_float(XS_DPP(__float_as_int(v), 0x141));
    if constexpr (W > 8) v += __int_as_float(XS_DPP(__float_as_int(v), 0x140));
    if constexpr (W > 16) { auto r = __builtin_amdgcn_permlane16_swap(__float_as_uint(v), __float_as_uint(v), false, false); v = __uint_as_float(r[0]) + __uint_as_float(r[1]); }
    if constexpr (W > 32) { auto r = __builtin_amdgcn_permlane32_swap(__float_as_uint(v), __float_as_uint(v), false, false); v = __uint_as_float(r[0]) + __uint_as_float(r[1]); }
    return v;
}
template <int W> __device__ __forceinline__ int xsum_i(int v) {
    if constexpr (W > 1) v += XS_DPP(v, 0xB1);
    if constexpr (W > 2) v += XS_DPP(v, 0x4E);
    if constexpr (W > 4) v += XS_DPP(v, 0x141);
    if constexpr (W > 8) v += XS_DPP(v, 0x140);
    if constexpr (W > 16) { auto r = __builtin_amdgcn_permlane16_swap((unsigned)v, (unsigned)v, false, false); v = (int)(r[0] + r[1]); }
    if constexpr (W > 32) { auto r = __builtin_amdgcn_permlane32_swap((unsigned)v, (unsigned)v, false, false); v = (int)(r[0] + r[1]); }
    return v;
}
template <int W> __device__ __forceinline__ unsigned xmax_u(unsigned v) {
    if constexpr (W > 1) v = max(v, (unsigned)XS_DPP((int)v, 0xB1));
    if constexpr (W > 2) v = max(v, (unsigned)XS_DPP((int)v, 0x4E));
    if constexpr (W > 4) v = max(v, (unsigned)XS_DPP((int)v, 0x141));
    if constexpr (W > 8) v = max(v, (unsigned)XS_DPP((int)v, 0x140));
    if constexpr (W > 16) { auto r = __builtin_amdgcn_permlane16_swap(v, v, false, false); v = max(r[0], r[1]); }
    if constexpr (W > 32) { auto r = __builtin_amdgcn_permlane32_swap(v, v, false, false); v = max(r[0], r[1]); }
    return v;
}
template <int W> __device__ __forceinline__ unsigned xmin_u(unsigned v) { return ~xmax_u<W>(~v); }
__device__ __forceinline__ float wave_sum(float v) { return xsum<64>(v); }
__device__ __forceinline__ int q_next(Frame& F, int q) {
    __syncthreads();
    if (F.tid == 0) F.MISC[0] = __hip_atomic_fetch_add(F.ctl + CW_QUEUE + 64 * q, 1u, RLX_AGENT);
    __syncthreads();
    return (int)F.MISC[0];
}

struct XD { const float* src; bf16* dst; int ldsrc, lddst, width; float wsc; };
__device__ __forceinline__ void xpose_load(const XD& d, int lane, float (&v)[32]) {
    const int c = lane & 31, h = lane >> 5, cc = min(c, max(d.width - 1, 0));
    const unsigned lo = (unsigned)(h * d.ldsrc + cc) * 4u;
#pragma unroll
    for (int i = 0; i < 32; ++i) { const char* rb = (const char*)d.src + (size_t)(2 * i) * d.ldsrc * 4; v[i] = *(const float*)(rb + lo); }
}
__device__ __forceinline__ void xpose_emit(const XD& d, int lane, const float (&v)[32], LAS float* scr) {
    const int c = lane & 31, h = lane >> 5; const bool ok = c < d.width;
#pragma unroll
    for (int i = 0; i < 32; ++i) scr[(2 * i + h) * 33 + c] = ok ? v[i] * d.wsc : 0.f;
    LDS_WAIT(); asm volatile("" ::: "memory");
    const int c8 = lane & 7;
#pragma unroll
    for (int j = 0; j < 4; ++j) { const int n = (lane >> 3) + 8 * j; const LAS float* s = scr + (8 * c8) * 33 + n;
        v4u o; o.x = cvt_pk_bf16_nv(s[0 * 33], s[1 * 33]); o.y = cvt_pk_bf16_nv(s[2 * 33], s[3 * 33]); o.z = cvt_pk_bf16_nv(s[4 * 33], s[5 * 33]); o.w = cvt_pk_bf16_nv(s[6 * 33], s[7 * 33]);
        if (n < d.width) *(v4u*)(d.dst + (size_t)n * d.lddst + 8 * c8) = o; }
    LDS_WAIT(); asm volatile("" ::: "memory");
}
constexpr int XB_FF = 5632, XB_WIN = 32 * 151, XB_UQ = 7 * 48, XB_UKV = 2 * 64, XB_OUT = 32 * 64;
constexpr int XB_LAYER = 6 * XB_FF + XB_WIN + XB_UQ + XB_UKV + XB_OUT, XB_TOTAL = NLAYER * XB_LAYER;
constexpr int XPW = 2, XCHUNKS = (XB_TOTAL + 8 * XPW - 1) / (8 * XPW);
constexpr int ADA_ITEMS = NLAYER * 72, P0_ITEMS = ADA_ITEMS + XCHUNKS;
#define XD_SET(W_, ldsrc_, k0_, csrc_, width_, WT_, lddst_, drow_) do { d.src = (W_) + (size_t)(k0_) * (ldsrc_) + (csrc_); d.ldsrc = (ldsrc_); d.width = (width_); d.dst = (WT_) + (size_t)(drow_) * (lddst_) + (k0_); d.lddst = (lddst_); } while (0)
__device__ __forceinline__ XD xpose_desc(KParams p, int blk) {
    XD d; d.src = p->in[I_WOUT]; d.dst = (bf16*)(p->ws + WS_W); d.ldsrc = 0; d.lddst = 0; d.width = 0; d.wsc = 1.0f;
    if (blk >= XB_TOTAL) return d;
    const int l = blk / XB_LAYER; int r = blk % XB_LAYER;
    unsigned char* wl = p->ws + WS_W + (size_t)l * LW_BYTES;
    if (r < 6 * XB_FF) {
        const int j = r / XB_FF, b = r % XB_FF, f2 = j / 3, jj = j % 3;
        if (jj < 2) { const int kb = b / 176, nb = b % 176, n = 32 * nb;
            const float* W = p->in[(f2 ? I_W2G : I_W1G) + jj] + (size_t)l * DM * FF;
            XD_SET(W, FF, 64 * kb, n, 32, (bf16*)(wl + (f2 ? LW_GU2 : LW_GU1)), DM, (n >> 7) * 256 + (n & 127) + 128 * jj); d.wsc = jj == 0 ? -1.4426950408889634f : -0.6931471805599453f;
        } else { const int kb = b / 64, nb = b % 64;
            const float* W = p->in[f2 ? I_W2D : I_W1D] + (size_t)l * FF * DM;
            XD_SET(W, DM, 64 * kb, 32 * nb, 32, (bf16*)(wl + (f2 ? LW_DN2 : LW_DN1)), FF, 32 * nb); }
        return d; }
    r -= 6 * XB_FF;
    if (r < XB_WIN) { const int kb = r / 151, nb = r % 151;
        int s0, d0, w = 32, nb0;
        if (nb < 16) { s0 = 0; d0 = PC_QA; nb0 = 0; } else if (nb < 32) { s0 = 512; d0 = PC_KA; nb0 = 16; } else if (nb < 48) { s0 = 1024; d0 = PC_VA; nb0 = 32; }
        else if (nb < 80) { s0 = 1536; d0 = PC_QI; nb0 = 48; } else if (nb < 82) { s0 = 2560; d0 = PC_KI; nb0 = 80; } else if (nb < 83) { s0 = 2624; d0 = PC_WI; nb0 = 82; w = 16; }
        else if (nb < 97) { s0 = 2640; d0 = PC_CQ; nb0 = 83; } else if (nb < 101) { s0 = 3088; d0 = PC_CKV; nb0 = 97; } else if (nb < 103) { s0 = 3216; d0 = PC_KR; nb0 = 101; }
        else if (nb < 119) { s0 = 3280; d0 = PC_QC; nb0 = 103; } else if (nb < 135) { s0 = 3792; d0 = PC_KC; nb0 = 119; } else { s0 = 4304; d0 = PC_VC; nb0 = 135; }
        const int o = 32 * (nb - nb0);
        XD_SET(p->in[I_WIN] + (size_t)l * DM * NIN, NIN, 64 * kb, s0 + o, w, (bf16*)(wl + LW_IN), DM, d0 + o); return d; }
    r -= XB_WIN;
    if (r < XB_UQ) { const int kb = r / 48, nb = r % 48; XD_SET(p->in[I_WUQ] + (size_t)l * 448 * NQB, NQB, 64 * kb, 32 * nb, 32, (bf16*)(wl + LW_UQ), 512, 32 * nb); return d; }
    r -= XB_UQ;
    if (r < XB_UKV) { const int kb = r / 64, nb = r % 64; XD_SET(p->in[I_WUKV] + (size_t)l * 128 * NKVB, NKVB, 64 * kb, 32 * nb, 32, (bf16*)(wl + LW_UKV), 128, 32 * nb); return d; }
    r -= XB_UKV;
    { const int kb = r / 64, nb = r % 64; XD_SET(p->in[I_WOUT] + (size_t)l * DM * DM, DM, 64 * kb, 32 * nb, 32, (bf16*)(wl + LW_OUT), DM, 32 * nb); }
    return d;
}
#undef XD_SET
__device__ __forceinline__ void ada_item(Frame& F, KParams p, int it) {
    const int l = it / 72, cg = it % 72;
    LAS float* cact = (LAS float*)F.lds;
    LAS float* red = (LAS float*)(F.lds + 65536);
    for (int idx = F.tid; idx < NB * DM; idx += 512) { const int b = idx & 7, k = idx >> 3; const float c = p->in[I_C][b * DM + k]; cact[idx] = c * __builtin_amdgcn_rcpf(1.0f + __expf(-c)); }
    __syncthreads();
    const float* W = p->in[I_WADA] + (size_t)l * DM * NMOD + cg * 256 + 4 * F.lane;
    f32x4 acc[8];
#pragma unroll
    for (int b = 0; b < 8; ++b) acc[b] = (f32x4){0.f, 0.f, 0.f, 0.f};
#pragma unroll 8
    for (int k = F.wave; k < DM; k += 8) {
        const f32x4 w = *(const f32x4*)(W + (size_t)k * NMOD);
        const f32x4 c0 = *(const LAS f32x4*)(cact + k * 8), c1 = *(const LAS f32x4*)(cact + k * 8 + 4);
        acc[0] += w * c0[0]; acc[1] += w * c0[1]; acc[2] += w * c0[2]; acc[3] += w * c0[3];
        acc[4] += w * c1[0]; acc[5] += w * c1[1]; acc[6] += w * c1[2]; acc[7] += w * c1[3];
    }
#pragma unroll
    for (int b = 0; b < 8; ++b) *(LAS f32x4*)(red + (F.wave * 8 + b) * 256 + 4 * F.lane) = acc[b];
    __syncthreads();
    { const int b = F.tid >> 6; f32x4 s = (f32x4){0.f, 0.f, 0.f, 0.f};
#pragma unroll
      for (int w = 0; w < 8; ++w) s += *(const LAS f32x4*)(red + (w * 8 + b) * 256 + 4 * F.lane);
      const int col = cg * 256 + 4 * F.lane;
      s += *(const f32x4*)(p->in[I_BADA] + (size_t)l * NMOD + col);
      *(f32x4*)((float*)(p->ws + WS_MOD) + (size_t)(l * NB + b) * NMOD + col) = s; }
}
__device__ __forceinline__ void p0_prologue(Frame& F, KParams p) {
    const int gt = F.vcu * 512 + F.tid, NGT = F.G * 512;
    for (int l = 0; l < NLAYER; ++l) {
        bf16* win = (bf16*)(p->ws + WS_W + (size_t)l * LW_BYTES + LW_IN); bf16* wuq = (bf16*)(p->ws + WS_W + (size_t)l * LW_BYTES + LW_UQ);
        for (int e = gt; e < 304 * (DM / 8); e += NGT) { int r = e / (DM / 8); const int c = e % (DM / 8);
            r = r < 48 ? 2640 + r : (r < 112 ? 3136 + (r - 48) : 3392 + (r - 112));
            *(v4u*)(win + (size_t)r * DM + 8 * c) = (v4u){0u, 0u, 0u, 0u}; }
        for (int e = gt; e < NQB * 8; e += NGT) *(v4u*)(wuq + (size_t)(e >> 3) * 512 + 448 + 8 * (e & 7)) = (v4u){0u, 0u, 0u, 0u};
    }
    { float* tab = (float*)(p->ws + WS_TAB);
      for (int e = gt; e < SEQ * 48; e += NGT) { const int t = e / 48, j = e % 48; const bool part = j < 16; const int i = part ? j : j - 16;
          const double r = part ? 0.44036660267178046 : 0.6636012376960885; double inv = 1.0; for (int q = 0; q < i; ++q) inv *= r;
          const float ang = (float)t * (float)inv; const double rev = (double)ang * 0.15915494309189535; const float fr = (float)(rev - floor(rev));
          const float cs = __builtin_amdgcn_cosf(fr), sn = __builtin_amdgcn_sinf(fr);
          if (part) { tab[t * 96 + i] = cs; tab[t * 96 + 16 + i] = sn; } else { tab[t * 96 + 32 + i] = cs; tab[t * 96 + 64 + i] = sn; } } }
    LAS float* scr = (LAS float*)(F.lds + F.wave * 16384);
    int it = q_next(F, 0);
    for (; it < ADA_ITEMS; it = q_next(F, 0)) ada_item(F, p, it);
#define XBLK(item, j) ((((item) - ADA_ITEMS) * 8 + F.wave) * XPW + (j))
    if (it < P0_ITEMS) {
        float va0[32], va1[32], vb0[32], vb1[32];
        XD a0 = xpose_desc(p, XBLK(it, 0)), a1 = xpose_desc(p, XBLK(it, 1)), b0, b1;
        xpose_load(a0, F.lane, va0); xpose_load(a1, F.lane, va1);
        for (;;) {
            int nx = q_next(F, 0);
            b0 = xpose_desc(p, XBLK(nx, 0)); b1 = xpose_desc(p, XBLK(nx, 1)); xpose_load(b0, F.lane, vb0); xpose_load(b1, F.lane, vb1);
            xpose_emit(a0, F.lane, va0, scr); xpose_emit(a1, F.lane, va1, scr);
            if (nx >= P0_ITEMS) break;
            nx = q_next(F, 0);
            a0 = xpose_desc(p, XBLK(nx, 0)); a1 = xpose_desc(p, XBLK(nx, 1)); xpose_load(a0, F.lane, va0); xpose_load(a1, F.lane, va1);
            xpose_emit(b0, F.lane, vb0, scr); xpose_emit(b1, F.lane, vb1, scr);
            if (nx >= P0_ITEMS) break;
        }
    }
#undef XBLK
}

__device__ __forceinline__ void norm_phase(Frame& F, const float* x, const float* g, const float* modl, int ch_shift, int ch_scale, bf16* H) {
    const int gw = F.vcu * NWAVES + F.wave, NGW = F.G * NWAVES;
    for (int m0 = gw * 16; m0 < M; m0 += NGW * 16) {
        const int b = m0 >> 12;
        const float* sh = modl + (size_t)b * NMOD + ch_shift * DM + 4 * F.lane; const float* sc = modl + (size_t)b * NMOD + ch_scale * DM + 4 * F.lane; const float* gg = g + 4 * F.lane;
        f32x4 av[8], tv[8];
#pragma unroll
        for (int j = 0; j < 8; ++j) { av[j] = *(const f32x4*)(gg + 256 * j) * (*(const f32x4*)(sc + 256 * j) + 1.0f); tv[j] = *(const f32x4*)(sh + 256 * j); }
        const float* xr = x + (size_t)m0 * DM + 4 * F.lane;
        f32x4 v[8], vn[8];
#pragma unroll
        for (int j = 0; j < 8; ++j) v[j] = *(const f32x4*)(xr + 256 * j);
#pragma unroll 1
        for (int r = 0; r < 16; ++r) {
            if (r + 1 < 16) {
#pragma unroll
                for (int j = 0; j < 8; ++j) vn[j] = *(const f32x4*)(xr + (size_t)(r + 1) * DM + 256 * j); }
            float ss = 0.f;
#pragma unroll
            for (int j = 0; j < 8; ++j) ss += (v[j][0] * v[j][0] + v[j][1] * v[j][1]) + (v[j][2] * v[j][2] + v[j][3] * v[j][3]);
            const float rstd = rsqrtf(wave_sum(ss) * (1.0f / DM) + NORM_EPS);
            bf16* hr = H + (size_t)(m0 + r) * DM + 4 * F.lane;
#pragma unroll
            for (int j = 0; j < 8; ++j) { const f32x4 h = v[j] * rstd * av[j] + tv[j]; v2u w; w.x = cvt_pk_bf16(h[0], h[1]); w.y = cvt_pk_bf16(h[2], h[3]); *(v2u*)(hr + 256 * j) = w; }
#pragma unroll
            for (int j = 0; j < 8; ++j) v[j] = vn[j];
        }
    }
}

__device__ __forceinline__ void unpack8(LAS float* y, v4u w) { *(LAS f32x4*)y = (f32x4){bf_lo(w.x), bf_hi(w.x), bf_lo(w.y), bf_hi(w.y)}; *(LAS f32x4*)(y + 4) = (f32x4){bf_lo(w.z), bf_hi(w.z), bf_lo(w.w), bf_hi(w.w)}; }
__device__ __forceinline__ v4u pack8(const LAS float* y) { const f32x4 a = *(const LAS f32x4*)y, b = *(const LAS f32x4*)(y + 4); v4u w; w.x = cvt_pk_bf16(a[0], a[1]); w.y = cvt_pk_bf16(a[2], a[3]); w.z = cvt_pk_bf16(b[0], b[1]); w.w = cvt_pk_bf16(b[2], b[3]); return w; }
template <int NG, int LEN, int GS> __device__ __forceinline__ void norm_pass(LAS float* y, int start, const LAS float* g, int lane) {
    constexpr int LPG = 64 / NG, EPL = LEN / LPG; static_assert(LEN % LPG == 0, "norm_pass");
    const int grp = lane / LPG, li = lane % LPG; LAS float* yb = y + start + grp * GS + li;
    float v[EPL]; float ss = 0.f;
#pragma unroll
    for (int j = 0; j < EPL; ++j) { v[j] = yb[LPG * j]; ss += v[j] * v[j]; }
    ss = xsum<LPG>(ss);
    const float rstd = rsqrtf(ss * (1.0f / LEN) + NORM_EPS);
#pragma unroll
    for (int j = 0; j < EPL; ++j) yb[LPG * j] = v[j] * rstd * g[li + LPG * j];
}
__device__ __forceinline__ int post1_col(int i) { return i < 64 ? PC_QA + 8 * i : (i < 128 ? PC_KA + 8 * (i - 64) : (i < 184 ? PC_CQ + 8 * (i - 128) : (i < 200 ? PC_CKV + 8 * (i - 184) : PC_KR + 8 * (i - 200)))); }
__device__ __forceinline__ void post1_phase(Frame& F, KParams p, int l) {
    bf16* P = (bf16*)(p->ws + WS_P); const float* tab = (const float*)(p->ws + WS_TAB);
    LAS float* y = (LAS float*)(F.lds + F.wave * 8192);
    LAS float* G = (LAS float*)(F.lds + 65536);
    for (int i = F.tid; i < 896; i += 512) G[i] = i < 128 ? p->in[I_GQA][l * 128 + i] : (i < 256 ? p->in[I_GKA][l * 128 + i - 128] : (i < 704 ? p->in[I_GCQ][l * 448 + i - 256] : (i < 832 ? p->in[I_GCKV][l * 128 + i - 704] : p->in[I_GKR][l * 64 + i - 832])));
    __syncthreads();
    const int gw = F.vcu * NWAVES + F.wave, NGW = F.G * NWAVES, lane = F.lane;
    const int c1 = post1_col(lane + 64), c2 = post1_col(lane + 128), c3 = post1_col(lane < 16 ? lane + 192 : 192);
    v4u r1, r2, r3;
#define P1LOAD(m_) do { const bf16* row_ = P + (size_t)(m_) * NP; r1 = *(const v4u*)(row_ + c1); r2 = *(const v4u*)(row_ + c2); r3 = *(const v4u*)(row_ + c3); } while (0)
    if (gw < M) P1LOAD(gw);
    for (int m = gw; m < M; m += NGW) {
        const int t = m & (SEQ - 1); bf16* row = P + (size_t)m * NP;
        unpack8(y + 8 * (lane + 64), r1); unpack8(y + 8 * (lane + 128), r2); if (lane < 16) unpack8(y + 8 * (lane + 192), r3);
        const float* tb = tab + (size_t)t * 96;
        float rc[2], rs[2]; { const int i = lane & 15; rc[0] = tb[i]; rs[0] = tb[16 + i]; rc[1] = tb[32 + (lane & 31)]; rs[1] = tb[64 + (lane & 31)]; }
        if (m + NGW < M) P1LOAD(m + NGW);
        LDS_WAIT(); asm volatile("" ::: "memory");
        norm_pass<4, 128, 128>(y, 512, G + 128, lane); norm_pass<1, 448, 0>(y, 1024, G + 256, lane);
        {
          const int hf = lane >> 5, li = lane & 31; LAS float* yb = y + (hf ? 1600 : 1472) + li; const LAS float* gb = G + (hf ? 832 : 704) + li;
          const float v0 = yb[0], v1 = yb[32], v2 = hf ? 0.f : yb[64], v3 = hf ? 0.f : yb[96]; float ss = (v0 * v0 + v1 * v1) + (v2 * v2 + v3 * v3);
          ss = xsum<32>(ss);
          const float rstd = rsqrtf(ss * (hf ? 1.0f / 64 : 1.0f / 128) + NORM_EPS);
          yb[0] = v0 * rstd * gb[0]; yb[32] = v1 * rstd * gb[32]; if (!hf) { yb[64] = v2 * rstd * gb[64]; yb[96] = v3 * rstd * gb[96]; } }
        LDS_WAIT(); asm volatile("" ::: "memory");
#pragma unroll
        for (int k = 1; k < 2; ++k) { const int pr = lane + 64 * k, base = 128 * (pr >> 4), i = pr & 15; const float a = y[base + i], b = y[base + 16 + i], c = rc[0], s = rs[0];
            y[base + i] = a * c - b * s; y[base + 16 + i] = a * s + b * c; }
        if (lane < 32) { const float a = y[1600 + lane], b = y[1632 + lane], c = rc[1], s = rs[1]; y[1600 + lane] = a * c - b * s; y[1632 + lane] = a * s + b * c; }
        LDS_WAIT(); asm volatile("" ::: "memory");
        *(v4u*)(row + c1) = pack8(y + 8 * (lane + 64)); *(v4u*)(row + c2) = pack8(y + 8 * (lane + 128)); if (lane < 16) *(v4u*)(row + c3) = pack8(y + 8 * (lane + 192));
        LDS_WAIT(); asm volatile("" ::: "memory");
    }
#undef P1LOAD
}

namespace att {
constexpr int QBLK = 32, KVBLK = 64;
constexpr int SHM_V = 16384, SHM_K = 16384, SHM_KR = 8192;
constexpr int OFF_V = 0, OFF_K = 2 * SHM_V, OFF_KR = OFF_K + 2 * SHM_K, OFF_WS = OFF_KR + 2 * SHM_KR, OFF_QR = OFF_WS + NWAVES * 64 * 4, OFF_DONE = OFF_QR + NWAVES * 4096, SHM_ATTN = OFF_DONE + 16;
constexpr float L2E = 1.4426950408889634f;
#define KSWZ(row, colB) ((row) * 256 + ((colB) ^ (((row) & 7) << 4)))
#define KRSWZ(row, colB) ((row) * 128 + ((colB) ^ (((row) & 7) << 4)))
__device__ __forceinline__ int crow(int r, int hi) { return (r & 3) + 8 * (r >> 2) + 4 * hi; }
#ifndef ATT_PIPE_A
#define ATT_PIPE_A true
#endif
#ifndef ATT_SD_A
#define ATT_SD_A 2
#endif
#ifndef ATT_SD_B
#define ATT_SD_B 1
#endif
#ifndef ATT_PIPE_B
#define ATT_PIPE_B true
#endif
#ifndef ATT_PIPE_C
#define ATT_PIPE_C false
#endif
template <int MODE> struct Cfg;
template <> struct Cfg<0> { static constexpr float SCALE = 0.088388347648318440f; static constexpr int ND0 = 8, SDEPTH = ATT_SD_A; static constexpr bool PIPE = ATT_PIPE_A; };
template <> struct Cfg<1> { static constexpr float SCALE = 0.072168783648703220f; static constexpr int ND0 = 12, SDEPTH = ATT_SD_B; static constexpr bool PIPE = ATT_PIPE_B; };
template <> struct Cfg<2> { static constexpr float SCALE = 0.088388347648318440f; static constexpr int ND0 = 8, SDEPTH = 1; static constexpr bool PIPE = ATT_PIPE_C; };
constexpr float THR = 8.f;
template <int MODE> __device__ __forceinline__ void partialSM(f32x16& p0, f32x16& p1, float& m_reg, float& mn, float& alpha) {
    constexpr float SCALE = Cfg<MODE>::SCALE, C = SCALE * L2E;
    float pmax = p0[0];
#pragma unroll
    for (int r = 1; r < 16; ++r) pmax = fmaxf(pmax, p0[r]);
#pragma unroll
    for (int r = 0; r < 16; ++r) pmax = fmaxf(pmax, p1[r]);
    { auto rr = __builtin_amdgcn_permlane32_swap(__float_as_uint(pmax), __float_as_uint(pmax), false, false); pmax = fmaxf(__uint_as_float(rr[0]), __uint_as_float(rr[1])); }
    if (__builtin_expect(__all(pmax - m_reg <= THR / SCALE), 1)) { mn = m_reg; alpha = 1.f; }
    else { mn = fmaxf(m_reg, pmax); alpha = __builtin_amdgcn_exp2f((m_reg - mn) * C); m_reg = mn; }
    const float mnC = -mn * C;
#pragma unroll
    for (int r = 0; r < 16; ++r) p0[r] = fmaf(p0[r], C, mnC);
#pragma unroll
    for (int r = 0; r < 16; ++r) p1[r] = fmaf(p1[r], C, mnC);
#pragma unroll
    for (int r = 0; r < 16; ++r) p0[r] = __builtin_amdgcn_exp2f(p0[r]);
}
#define PK4(P, BASE, OUT) do { unsigned a0 = cvt_pk_bf16(P[BASE + 0], P[BASE + 1]), a1 = cvt_pk_bf16(P[BASE + 2], P[BASE + 3]);   \
    unsigned b0 = cvt_pk_bf16(P[BASE + 4], P[BASE + 5]), b1 = cvt_pk_bf16(P[BASE + 6], P[BASE + 7]);                              \
    auto r0 = __builtin_amdgcn_permlane32_swap(a0, b0, false, false); auto r1 = __builtin_amdgcn_permlane32_swap(a1, b1, false, false); \
    v4u w = {r0[0], r1[0], r0[1], r1[1]}; OUT = *reinterpret_cast<bf16x8*>(&w); } while (0)
__device__ __forceinline__ void finishSM(f32x16& p0, f32x16& p1, float alpha, float& l_reg, bf16x8& pa0, bf16x8& pa1, bf16x8& pa2, bf16x8& pa3) {
#pragma unroll
    for (int r = 0; r < 16; ++r) p1[r] = __builtin_amdgcn_exp2f(p1[r]);
    float ps = 0;
#pragma unroll
    for (int r = 0; r < 16; ++r) ps += p0[r];
#pragma unroll
    for (int r = 0; r < 16; ++r) ps += p1[r];
    { auto rr = __builtin_amdgcn_permlane32_swap(__float_as_uint(ps), __float_as_uint(ps), false, false); ps = __uint_as_float(rr[0]) + __uint_as_float(rr[1]); }
    l_reg = l_reg * alpha + ps;
    PK4(p0, 0, pa0); PK4(p0, 8, pa1); PK4(p1, 0, pa2); PK4(p1, 8, pa3);
}
__device__ __forceinline__ void packP(f32x16& p0, f32x16& p1, bf16x8& pa0, bf16x8& pa1, bf16x8& pa2, bf16x8& pa3) { PK4(p0, 0, pa0); PK4(p0, 8, pa1); PK4(p1, 0, pa2); PK4(p1, 8, pa3); }
__device__ __forceinline__ void stick_half(f32x16& p, const int cbase, const float Rin, float& T, const int lim2, const int hi, const float f0) {
    constexpr float SC = 0.088388347648318440f;
    float ls[16];
#pragma unroll
    for (int r = 0; r < 16; ++r) { const int c = (r & 3) + 8 * (r >> 2) + cbase;
        const float z = p[r] * SC; const float e = __builtin_amdgcn_exp2f(-fabsf(z) * L2E); const float sp = fmaxf(z, 0.f) + __builtin_amdgcn_logf(1.0f + e) * 0.6931471805599453f;
        p[r] = z; ls[r] = (c < lim2) ? -sp : 0.f; }
    float own[4], oth[4];
#pragma unroll
    for (int i = 0; i < 4; ++i) own[i] = (ls[4 * i] + ls[4 * i + 1]) + (ls[4 * i + 2] + ls[4 * i + 3]);
#pragma unroll
    for (int i = 0; i < 4; ++i) { auto rr = __builtin_amdgcn_permlane32_swap(__float_as_uint(own[i]), __float_as_uint(own[i]), false, false); oth[i] = hi ? __uint_as_float(rr[0]) : __uint_as_float(rr[1]); }
#pragma unroll
    for (int i = 3; i >= 0; --i) {
        const float l3 = Rin + T + oth[i] * f0;
        const int b = 4 * i, cb = 8 * i + cbase;
        const float l2 = l3 + ls[b + 3], l1 = l2 + ls[b + 2], l0 = l1 + ls[b + 1];
        p[b + 3] = (cb + 3 < lim2) ? __builtin_amdgcn_exp2f((p[b + 3] + ls[b + 3] + l3) * L2E) : 0.f; p[b + 2] = (cb + 2 < lim2) ? __builtin_amdgcn_exp2f((p[b + 2] + ls[b + 2] + l2) * L2E) : 0.f;
        p[b + 1] = (cb + 1 < lim2) ? __builtin_amdgcn_exp2f((p[b + 1] + ls[b + 1] + l1) * L2E) : 0.f; p[b + 0] = (cb + 0 < lim2) ? __builtin_amdgcn_exp2f((p[b + 0] + ls[b + 0] + l0) * L2E) : 0.f;
        T += own[i] + oth[i];
    }
}
__device__ __forceinline__ void stickSM(f32x16& p0, f32x16& p1, float& R, int lim2, int hi) {
    const float f0 = hi ? 0.f : 1.f; float T = 0.f;
    stick_half(p1, 32, R, T, lim2, hi, f0); asm volatile("" : "+v"(T));
    stick_half(p0, 0, R, T, lim2, hi, f0);
    R += T;
}
__device__ __forceinline__ void maskA(f32x16& p0, f32x16& p1, unsigned w0, unsigned w1, int hi) {
    const unsigned a = w0 >> (4 * hi), b = w1 >> (4 * hi);
#pragma unroll
    for (int r = 0; r < 16; ++r) { const unsigned bit = 1u << ((r & 3) + 8 * (r >> 2)); p0[r] = (a & bit) ? p0[r] : -INFINITY; p1[r] = (b & bit) ? p1[r] : -INFINITY; }
}
template <int ND0> __device__ __forceinline__ void qkt(f32x16& p0, f32x16& p1, const char* Ks, const char* Krs, const bf16x8* qr, const char* qrl, int r32, int hi) {
    p0 = f32x16{}; p1 = f32x16{};
#pragma unroll
    for (int d0 = 0; d0 < 8; ++d0) { const int cb = (d0 * 16 + hi * 8) * 2;
        const bf16x8 b0 = *reinterpret_cast<const bf16x8*>(Ks + KSWZ(r32, cb)), b1 = *reinterpret_cast<const bf16x8*>(Ks + KSWZ(32 + r32, cb));
        p0 = __builtin_amdgcn_mfma_f32_32x32x16_bf16(b0, qr[d0], p0, 0, 0, 0); p1 = __builtin_amdgcn_mfma_f32_32x32x16_bf16(b1, qr[d0], p1, 0, 0, 0); }
    if constexpr (ND0 == 12) {
#pragma unroll
        for (int d0 = 0; d0 < 4; ++d0) { const int cb = (d0 * 16 + hi * 8) * 2;
            const bf16x8 b0 = *reinterpret_cast<const bf16x8*>(Krs + KRSWZ(r32, cb)), b1 = *reinterpret_cast<const bf16x8*>(Krs + KRSWZ(32 + r32, cb));
            const bf16x8 qv = *reinterpret_cast<const bf16x8*>(qrl + d0 * 1024);
            p0 = __builtin_amdgcn_mfma_f32_32x32x16_bf16(b0, qv, p0, 0, 0, 0); p1 = __builtin_amdgcn_mfma_f32_32x32x16_bf16(b1, qv, p1, 0, 0, 0); } }
}
__device__ __forceinline__ int v_st(int k, int c) { const int kk = (k & ~0xC) | ((k & 4) << 1) | ((k & 8) >> 1); return ((kk >> 3) * 4 + (c >> 5)) * 512 + ((kk & 7) * 32 + (c & 31)) * 2; }
__device__ __forceinline__ int v_rd_base(int lane) { return ((lane & 3) << 3) | (((lane >> 2) & 3) << 6) | (((lane >> 4) & 1) << 5) | (((lane >> 5) & 1) << 8); }
constexpr int v_rd_off(int d0, int ks, int half) { return d0 * 512 + ks * 4096 + half * 2048; }
template <int OFF> __device__ __forceinline__ s16x4 tr_read(int vb) { s16x4 r; asm volatile("ds_read_b64_tr_b16 %0, %1 offset:%2" : "=&v"(r) : "v"(vb), "i"(OFF) : "memory"); return r; }
template <int D0> __device__ __forceinline__ void pv_one(f32x16& od, int vb, bf16x8 pa0, bf16x8 pa1, bf16x8 pa2, bf16x8 pa3) {
    const s16x4 l0 = tr_read<v_rd_off(D0, 0, 0)>(vb), h0 = tr_read<v_rd_off(D0, 0, 1)>(vb), l1 = tr_read<v_rd_off(D0, 1, 0)>(vb), h1 = tr_read<v_rd_off(D0, 1, 1)>(vb);
    const s16x4 l2 = tr_read<v_rd_off(D0, 2, 0)>(vb), h2 = tr_read<v_rd_off(D0, 2, 1)>(vb), l3 = tr_read<v_rd_off(D0, 3, 0)>(vb), h3 = tr_read<v_rd_off(D0, 3, 1)>(vb);
    asm volatile("s_waitcnt lgkmcnt(0)" ::: "memory"); SBAR();
#define PKV(L, H) (bf16x8){L[0], L[1], L[2], L[3], H[0], H[1], H[2], H[3]}
    od = __builtin_amdgcn_mfma_f32_32x32x16_bf16(pa0, PKV(l0, h0), od, 0, 0, 0);
    od = __builtin_amdgcn_mfma_f32_32x32x16_bf16(pa1, PKV(l1, h1), od, 0, 0, 0);
    od = __builtin_amdgcn_mfma_f32_32x32x16_bf16(pa2, PKV(l2, h2), od, 0, 0, 0);
    od = __builtin_amdgcn_mfma_f32_32x32x16_bf16(pa3, PKV(l3, h3), od, 0, 0, 0);
#undef PKV
}
__device__ __forceinline__ void pv_d0(f32x16* o, int vb, bf16x8 pa0, bf16x8 pa1, bf16x8 pa2, bf16x8 pa3) {
    pv_one<0>(o[0], vb, pa0, pa1, pa2, pa3); pv_one<1>(o[1], vb, pa0, pa1, pa2, pa3); pv_one<2>(o[2], vb, pa0, pa1, pa2, pa3); pv_one<3>(o[3], vb, pa0, pa1, pa2, pa3);
}

template <int MODE>
__device__ __forceinline__ void attn_unit(const bf16* __restrict__ Qb, int ldq, const bf16* __restrict__ Kh, const bf16* __restrict__ Vh, int ldk, const bf16* __restrict__ Krh,
                                          bf16* __restrict__ Ob, int ldo, int NT, int t0, const unsigned* __restrict__ mrow, char* lds, int wv,
                                          const float* __restrict__ gqn = nullptr, const float* __restrict__ gqr = nullptr, const float* __restrict__ tab = nullptr) {
    constexpr int ND0 = Cfg<MODE>::ND0, SDEPTH = Cfg<MODE>::SDEPTH;
    int wv_ = wv; asm volatile("" : "+s"(wv_)); int tid_ = (wv_ << 6) | lane_id_fresh(); tid_ &= 511;
    const int tid = tid_, wid = tid >> 6, lane = tid & 63, r32 = lane & 31, hi = lane >> 5;
    if (wv_ >= 4) __builtin_amdgcn_s_setprio(1);
    char* V_lds = lds + OFF_V; char* K_lds = lds + OFF_K; char* KR_lds = lds + OFF_KR;
    float* ws = (float*)(lds + OFF_WS) + wid * 64; float* li_l = ws; float* al_l = ws + 32;
    float m_reg = -1e30f, l_reg = 0.f, R = 0.f; f32x16 o[4] = {}; bf16x8 qr[8];
    const bf16* Qw = Qb + (size_t)(wid * QBLK + r32) * ldq + hi * 8;
    char* qrl = lds + OFF_QR + wid * 4096 + lane * 16;
    if constexpr (MODE == 0 || MODE == 1) {
        float qf[8][8]; float ss = 0.f;
#pragma unroll
        for (int d0 = 0; d0 < 8; ++d0) { const v4u w = *reinterpret_cast<const v4u*>(Qw + d0 * 16);
            qf[d0][0] = bf_lo(w.x); qf[d0][1] = bf_hi(w.x); qf[d0][2] = bf_lo(w.y); qf[d0][3] = bf_hi(w.y); qf[d0][4] = bf_lo(w.z); qf[d0][5] = bf_hi(w.z); qf[d0][6] = bf_lo(w.w); qf[d0][7] = bf_hi(w.w); }
#pragma unroll
        for (int d0 = 0; d0 < 8; ++d0)
#pragma unroll
            for (int j = 0; j < 8; ++j) ss += qf[d0][j] * qf[d0][j];
        { auto r = __builtin_amdgcn_permlane32_swap(__float_as_uint(ss), __float_as_uint(ss), false, false); ss = __uint_as_float(r[0]) + __uint_as_float(r[1]); }
        const float rstd = rsqrtf(ss * (1.0f / 128) + NORM_EPS);
        const float* tb = tab + (size_t)(t0 + wid * QBLK + r32) * 96;
#pragma unroll
        for (int d0 = 0; d0 < 8; ++d0) { const f32x4 g0 = *reinterpret_cast<const f32x4*>(gqn + d0 * 16 + hi * 8), g1 = *reinterpret_cast<const f32x4*>(gqn + d0 * 16 + hi * 8 + 4);
#pragma unroll
            for (int j = 0; j < 4; ++j) { qf[d0][j] = qf[d0][j] * rstd * g0[j]; qf[d0][4 + j] = qf[d0][4 + j] * rstd * g1[j]; } }
        if constexpr (MODE == 0) {
            const int i0 = hi * 8;
            const f32x4 c0 = *reinterpret_cast<const f32x4*>(tb + i0), c1 = *reinterpret_cast<const f32x4*>(tb + i0 + 4), s0 = *reinterpret_cast<const f32x4*>(tb + 16 + i0), s1 = *reinterpret_cast<const f32x4*>(tb + 16 + i0 + 4);
#pragma unroll
            for (int j = 0; j < 8; ++j) { const float c = j < 4 ? c0[j & 3] : c1[j & 3], s = j < 4 ? s0[j & 3] : s1[j & 3], a = qf[0][j], b = qf[1][j];
                qf[0][j] = a * c - b * s; qf[1][j] = a * s + b * c; }
        }
#pragma unroll
        for (int d0 = 0; d0 < 8; ++d0) { v4u w; w.x = cvt_pk_bf16(qf[d0][0], qf[d0][1]); w.y = cvt_pk_bf16(qf[d0][2], qf[d0][3]); w.z = cvt_pk_bf16(qf[d0][4], qf[d0][5]); w.w = cvt_pk_bf16(qf[d0][6], qf[d0][7]);
            qr[d0] = *reinterpret_cast<bf16x8*>(&w); }
        if constexpr (MODE == 1) {
            float rf[4][8]; float s2 = 0.f;
#pragma unroll
            for (int d0 = 0; d0 < 4; ++d0) { const v4u w = *reinterpret_cast<const v4u*>(Qw + (8 + d0) * 16);
                rf[d0][0] = bf_lo(w.x); rf[d0][1] = bf_hi(w.x); rf[d0][2] = bf_lo(w.y); rf[d0][3] = bf_hi(w.y); rf[d0][4] = bf_lo(w.z); rf[d0][5] = bf_hi(w.z); rf[d0][6] = bf_lo(w.w); rf[d0][7] = bf_hi(w.w); }
#pragma unroll
            for (int d0 = 0; d0 < 4; ++d0)
#pragma unroll
                for (int j = 0; j < 8; ++j) s2 += rf[d0][j] * rf[d0][j];
            { auto r = __builtin_amdgcn_permlane32_swap(__float_as_uint(s2), __float_as_uint(s2), false, false); s2 = __uint_as_float(r[0]) + __uint_as_float(r[1]); }
            const float rstd2 = rsqrtf(s2 * (1.0f / 64) + NORM_EPS);
#pragma unroll
            for (int d0 = 0; d0 < 4; ++d0) { const f32x4 g0 = *reinterpret_cast<const f32x4*>(gqr + d0 * 16 + hi * 8), g1 = *reinterpret_cast<const f32x4*>(gqr + d0 * 16 + hi * 8 + 4);
#pragma unroll
                for (int j = 0; j < 4; ++j) { rf[d0][j] = rf[d0][j] * rstd2 * g0[j]; rf[d0][4 + j] = rf[d0][4 + j] * rstd2 * g1[j]; } }
#pragma unroll
            for (int d0 = 0; d0 < 2; ++d0) { const int i0 = d0 * 16 + hi * 8;
                const f32x4 c0 = *reinterpret_cast<const f32x4*>(tb + 32 + i0), c1 = *reinterpret_cast<const f32x4*>(tb + 32 + i0 + 4), s0 = *reinterpret_cast<const f32x4*>(tb + 64 + i0), s1 = *reinterpret_cast<const f32x4*>(tb + 64 + i0 + 4);
#pragma unroll
                for (int j = 0; j < 8; ++j) { const float c = j < 4 ? c0[j & 3] : c1[j & 3], s = j < 4 ? s0[j & 3] : s1[j & 3], a = rf[d0][j], b = rf[d0 + 2][j];
                    rf[d0][j] = a * c - b * s; rf[d0 + 2][j] = a * s + b * c; } }
#pragma unroll
            for (int d0 = 0; d0 < 4; ++d0) { v4u w; w.x = cvt_pk_bf16(rf[d0][0], rf[d0][1]); w.y = cvt_pk_bf16(rf[d0][2], rf[d0][3]); w.z = cvt_pk_bf16(rf[d0][4], rf[d0][5]); w.w = cvt_pk_bf16(rf[d0][6], rf[d0][7]);
                *reinterpret_cast<v4u*>(qrl + d0 * 1024) = w; }
        }
    } else {
#pragma unroll
        for (int d0 = 0; d0 < 8; ++d0) qr[d0] = *reinterpret_cast<const bf16x8*>(Qw + d0 * 16);
    }
    const int sr = tid >> 4, sc = (tid & 15) * 8, vst0 = v_st(sr, sc), vst1 = v_st(32 + sr, sc);
    const int krr = tid >> 3, krc = (tid & 7) * 8;
    const int vb0 = (int)(uintptr_t)V_lds + v_rd_base(lane);
    const int cw = (t0 >> 6) + (wid >> 1);
    const unsigned* mlane = mrow + (size_t)(wid * QBLK + r32) * 128;
    struct { bf16x8 vs0, vs1, ks0, ks1, kr; } sr_[SDEPTH];
#define TILE(j) (MODE == 2 ? (NT - 1 - (j)) : (j))
#define SLOAD(i, j) do { const int k0_ = TILE(j) * KVBLK; sr_[i].vs0 = *reinterpret_cast<const bf16x8*>(&Vh[(size_t)(k0_ + sr) * ldk + sc]); sr_[i].vs1 = *reinterpret_cast<const bf16x8*>(&Vh[(size_t)(k0_ + 32 + sr) * ldk + sc]); \
    sr_[i].ks0 = *reinterpret_cast<const bf16x8*>(&Kh[(size_t)(k0_ + sr) * ldk + sc]); sr_[i].ks1 = *reinterpret_cast<const bf16x8*>(&Kh[(size_t)(k0_ + 32 + sr) * ldk + sc]); \
    if constexpr (MODE == 1) sr_[i].kr = *reinterpret_cast<const bf16x8*>(&Krh[(size_t)(k0_ + krr) * NP + krc]); } while (0)
#define SWRITE(b, i) do { *(bf16x8*)(V_lds + (b) * SHM_V + vst0) = sr_[i].vs0; *(bf16x8*)(V_lds + (b) * SHM_V + vst1) = sr_[i].vs1; const int kc_ = sc * 2;   \
    *(bf16x8*)(K_lds + (b) * SHM_K + KSWZ(sr, kc_)) = sr_[i].ks0; *(bf16x8*)(K_lds + (b) * SHM_K + KSWZ(32 + sr, kc_)) = sr_[i].ks1;               \
    if constexpr (MODE == 1) *(bf16x8*)(KR_lds + (b) * SHM_KR + KRSWZ(krr, krc * 2)) = sr_[i].kr; } while (0)
#define SWAIT() do { if constexpr (SDEPTH == 2) asm volatile("s_waitcnt vmcnt(4)" ::: "memory"); else asm volatile("s_waitcnt vmcnt(0)" ::: "memory"); } while (0)
#define RESC(a) do { if constexpr (MODE != 2) { if (__any((a) < 1.f)) { if (hi == 0) al_l[r32] = (a); asm volatile("s_waitcnt lgkmcnt(0)" ::: "memory"); \
    _Pragma("unroll") for (int d = 0; d < 4; ++d) _Pragma("unroll") for (int r = 0; r < 16; ++r) o[d][r] *= al_l[crow(r, hi)]; } } } while (0)
#define MLOAD(w0, w1, j) do { if constexpr (MODE == 0) { const v2u mw_ = *reinterpret_cast<const v2u*>(mlane + 2 * TILE(j)); w0 = mw_.x; w1 = mw_.y; } } while (0)
#define PART(P0, P1, MN, AL, w0, w1, j) do { const int jj_ = TILE(j); \
    if constexpr (MODE == 0) { maskA(P0, P1, w0, w1, hi); partialSM<0>(P0, P1, m_reg, MN, AL); } \
    else if constexpr (MODE == 1) { if (jj_ > cw) { _Pragma("unroll") for (int r = 0; r < 16; ++r) { P0[r] = -INFINITY; P1[r] = -INFINITY; } } partialSM<1>(P0, P1, m_reg, MN, AL); } \
    else { const int lim_ = jj_ < cw ? 64 : (jj_ > cw ? 0 : 32 * (wid & 1) + r32); stickSM(P0, P1, R, lim_ - 4 * hi, hi); } } while (0)
#define FIN(P0, P1, AL) do { if constexpr (MODE == 2) packP(P0, P1, pa0, pa1, pa2, pa3); else finishSM(P0, P1, AL, l_reg, pa0, pa1, pa2, pa3); } while (0)
    f32x16 pA0, pA1; float mnA = 0.f, alA = 1.f; bf16x8 pa0, pa1, pa2, pa3; unsigned mA0 = 0, mA1 = 0;
    (void)mnA;
    if constexpr (!Cfg<MODE>::PIPE) {
    volatile LAS unsigned* dn = (volatile LAS unsigned*)(lds + OFF_DONE); int ds = 0;
    if constexpr (MODE == 2) { if (tid < 3) dn[tid] = 0u; }
    SLOAD(0, 0); asm volatile("s_waitcnt vmcnt(0)" ::: "memory"); SWRITE(0, 0); __syncthreads();
    for (int j = 0; j < NT; ++j) {
        const int buf = j & 1;
        MLOAD(mA0, mA1, j);
        if (j + 1 < NT) SLOAD(0, j + 1);
        SBAR();
        qkt<ND0>(pA0, pA1, K_lds + buf * SHM_K, KR_lds + buf * SHM_KR, qr, qrl, r32, hi);
        PART(pA0, pA1, mnA, alA, mA0, mA1, j);
        FIN(pA0, pA1, alA);
        RESC(alA);
        SBAR();
        pv_d0(o, vb0 + buf * SHM_V, pa0, pa1, pa2, pa3);
        if (j + 1 < NT) { asm volatile("s_waitcnt vmcnt(0)" ::: "memory"); SWRITE(buf ^ 1, 0); }
        if constexpr (MODE == 2) { if (__all(R < -120.f) && lane == 0) __hip_atomic_fetch_add((LAS unsigned*)(lds + OFF_DONE) + ds, 1u, __ATOMIC_RELAXED, __HIP_MEMORY_SCOPE_WORKGROUP); }
        __syncthreads();
        if constexpr (MODE == 2) { const unsigned c_ = dn[ds]; const int zs = ds == 0 ? 2 : ds - 1; if (tid == 0) dn[zs] = 0u; ds = ds == 2 ? 0 : ds + 1; if (c_ == NWAVES) break; }
    }
    } else {
    f32x16 pB0, pB1; float mnB = 0.f, alB = 1.f; unsigned mB0 = 0, mB1 = 0; (void)mnB;
    constexpr int SE = 0, SO = SDEPTH - 1;
    SLOAD(SE, 0); MLOAD(mA0, mA1, 0); asm volatile("s_waitcnt vmcnt(0)" ::: "memory"); SWRITE(0, SE); __syncthreads();
    qkt<ND0>(pA0, pA1, K_lds, KR_lds, qr, qrl, r32, hi); PART(pA0, pA1, mnA, alA, mA0, mA1, 0);
    SLOAD(SO, 1); if constexpr (SDEPTH == 2) { if (2 < NT) SLOAD(SE, 2); }
    SWAIT(); SWRITE(1, SO); __syncthreads();
    for (int j = 1; j + 1 < NT; j += 2) {
        SBAR(); MLOAD(mB0, mB1, j); qkt<ND0>(pB0, pB1, K_lds + SHM_K, KR_lds + SHM_KR, qr, qrl, r32, hi);
        FIN(pA0, pA1, alA); SBAR();
        SLOAD(SO, j + SDEPTH); SBAR();
        pv_d0(o, vb0, pa0, pa1, pa2, pa3); PART(pB0, pB1, mnB, alB, mB0, mB1, j);
        __syncthreads(); SWAIT(); SWRITE(0, SE);
        RESC(alB); __syncthreads();
        SBAR(); MLOAD(mA0, mA1, j + 1); qkt<ND0>(pA0, pA1, K_lds, KR_lds, qr, qrl, r32, hi);
        FIN(pB0, pB1, alB); SBAR();
        if (SDEPTH == 1 || j + 3 < NT) SLOAD(SE, j + 1 + SDEPTH); SBAR();
        pv_d0(o, vb0 + SHM_V, pa0, pa1, pa2, pa3); PART(pA0, pA1, mnA, alA, mA0, mA1, j + 1);
        __syncthreads(); SWAIT(); SWRITE(1, SO);
        RESC(alA); __syncthreads();
    }
    SBAR(); MLOAD(mB0, mB1, NT - 1); qkt<ND0>(pB0, pB1, K_lds + SHM_K, KR_lds + SHM_KR, qr, qrl, r32, hi);
    FIN(pA0, pA1, alA); SBAR();
    pv_d0(o, vb0, pa0, pa1, pa2, pa3); PART(pB0, pB1, mnB, alB, mB0, mB1, NT - 1);
    __syncthreads(); RESC(alB);
    FIN(pB0, pB1, alB); SBAR();
    pv_d0(o, vb0 + SHM_V, pa0, pa1, pa2, pa3);
    __syncthreads();
    }
    float rli[16];
    if constexpr (MODE != 2) { if (hi == 0) li_l[r32] = l_reg; asm volatile("s_waitcnt lgkmcnt(0)" ::: "memory");
#pragma unroll
        for (int r = 0; r < 16; ++r) rli[r] = __builtin_amdgcn_rcpf(li_l[crow(r, hi)]); }
    else {
#pragma unroll
        for (int r = 0; r < 16; ++r) rli[r] = 1.f; }
    bf16* Ow = Ob + (size_t)(wid * QBLK) * ldo;
    LAS unsigned char* ot = (LAS unsigned char*)lds + wid * 8192;
#pragma unroll
    for (int r = 0; r < 16; ++r) { const int orow = crow(r, hi);
#pragma unroll
        for (int d0 = 0; d0 < 4; ++d0) *(LAS bf16*)(ot + orow * 256 + (d0 * 32 + r32) * 2) = (bf16)(cvt_pk_bf16(o[d0][r] * rli[r], 0.f) & 0xffffu); }
    asm volatile("s_waitcnt lgkmcnt(0)" ::: "memory");
#pragma unroll
    for (int k = 0; k < 8; ++k) { const int row = 4 * k + (lane >> 4), cp = lane & 15;
        const v4u v = *(const LAS v4u*)(ot + row * 256 + cp * 16); *(v4u*)(Ow + (size_t)row * ldo + cp * 8) = v; }
    __builtin_amdgcn_s_setprio(0);
    __syncthreads();
#undef TILE
#undef SLOAD
#undef SWRITE
#undef SWAIT
#undef RESC
#undef MLOAD
#undef PART
#undef FIN
}
}

__device__ __forceinline__ unsigned ordkey(float f) { const unsigned u = __float_as_uint(f); return u ^ ((unsigned)((int)u >> 31) | 0x80000000u); }
__device__ __forceinline__ unsigned keyinv(unsigned k) { return k ^ ((unsigned)(~((int)k >> 31)) | 0x80000000u); }
__device__ __forceinline__ void indexer_unit(KParams p, int b, int u16, LAS unsigned char* lds, int tid) {
    const int wave = __builtin_amdgcn_readfirstlane(tid >> 6), lane = tid & 63, r32 = lane & 31, hi = lane >> 5;
    const int t0 = 16 * u16, m0 = b * SEQ + t0, c = t0 >> 6, ng = 2 * (c + 1), ntile = (ng + 7) >> 3;
    const bf16* P = (const bf16*)(p->ws + WS_P); const bf16* KI = P + (size_t)b * SEQ * NP + PC_KI; unsigned* MASK = (unsigned*)(p->ws + WS_MASK);
    bf16x8 aq[4];
    { const bf16* qp = P + (size_t)(m0 + 2 * wave + (r32 >> 4)) * NP + PC_QI + (r32 & 15) * 64 + 8 * hi;
#pragma unroll
      for (int s = 0; s < 4; ++s) aq[s] = *reinterpret_cast<const bf16x8*>(qp + 16 * s); }
    float wv[16];
#pragma unroll
    for (int r = 0; r < 16; ++r) { const int q = r >> 3, h = (r & 3) + 8 * ((r >> 2) & 1) + 4 * hi; wv[r] = __uint_as_float((unsigned)P[(size_t)(m0 + 2 * wave + q) * NP + PC_WI + h] << 16) * 0.03125f; }
    unsigned kx[128];
#pragma unroll
    for (int g = 0; g < 128; ++g) kx[g] = 0u;
    const int dkey = lane >> 3, dslot = lane & 7;
#define ILOAD(T, buf) do { _Pragma("unroll") for (int k = 0; k < 4; ++k) { const int key = 32 * wave + 8 * k + dkey; \
        __builtin_amdgcn_global_load_lds((const unsigned*)(KI + (size_t)((T) * 256 + key) * NP + 8 * (dslot ^ ((key >> 1) & 7))), (LAS unsigned*)(lds + (buf) * 32768 + 4096 * wave + 1024 * k), 16, 0, 0); } } while (0)
    ILOAD(0, 0);
    if (ntile > 1) { ILOAD(1, 1); asm volatile("s_waitcnt vmcnt(4)" ::: "memory"); } else { asm volatile("s_waitcnt vmcnt(0)" ::: "memory"); }
    __syncthreads();
    int cb = 0;
#pragma unroll 1
    for (int T = 0; T < ntile; ++T) {
        const bool more = T + 2 < ntile;
        if (more) { const int nb = cb == 0 ? 2 : cb - 1; ILOAD(T + 2, nb); }
        const LAS unsigned char* kb = lds + cb * 32768;
#pragma unroll
        for (int hf = 0; hf < 2; ++hf) {
        unsigned tk[4];
#define IDX_MMA(ACC, gi_) do { const LAS unsigned char* kr_ = kb + ((gi_) * 32 + r32) * 128; const int sw_ = (r32 >> 1) & 7; bf16x8 kf_[4]; \
            _Pragma("unroll") for (int s = 0; s < 4; ++s) kf_[s] = *(const LAS bf16x8*)(kr_ + (((2 * s + hi) ^ sw_) << 4)); \
            __builtin_amdgcn_s_setprio(1); ACC = f32x16{}; \
            _Pragma("unroll") for (int s = 0; s < 4; ++s) ACC = __builtin_amdgcn_mfma_f32_32x32x16_bf16(aq[s], kf_[s], ACC, 0, 0, 0); \
            __builtin_amdgcn_s_setprio(0); } while (0)
#define IDX_RELU(x) __int_as_float(max(__float_as_int(x), 0))
#define IDX_SCORE(ACC, g4_) do { float s0_ = 0.f, s1_ = 0.f; \
            _Pragma("unroll") for (int r = 0; r < 8; ++r) { s0_ = fmaf(wv[r], IDX_RELU(ACC[r]), s0_); s1_ = fmaf(wv[8 + r], IDX_RELU(ACC[8 + r]), s1_); } \
            auto rr_ = __builtin_amdgcn_permlane32_swap(__float_as_uint(s0_), __float_as_uint(s1_), false, false); \
            tk[g4_] = (T * 8 + 4 * hf + (g4_) < ng) ? ordkey(__uint_as_float(rr_[0]) + __uint_as_float(rr_[1])) : 0u; } while (0)
        f32x16 accA, accB;
        IDX_MMA(accA, 4 * hf + 0);
        IDX_MMA(accB, 4 * hf + 1); IDX_SCORE(accA, 0);
        IDX_MMA(accA, 4 * hf + 2); IDX_SCORE(accB, 1);
        IDX_MMA(accB, 4 * hf + 3); IDX_SCORE(accA, 2);
        IDX_SCORE(accB, 3);
#undef IDX_MMA
#undef IDX_RELU
#undef IDX_SCORE
        switch (T) {
#define KXCASE(n) case n: _Pragma("unroll") for (int i = 0; i < 4; ++i) kx[8 * n + 4 * hf + i] = tk[i]; break;
            KXCASE(0) KXCASE(1) KXCASE(2) KXCASE(3) KXCASE(4) KXCASE(5) KXCASE(6) KXCASE(7) KXCASE(8) KXCASE(9) KXCASE(10) KXCASE(11) KXCASE(12) KXCASE(13) KXCASE(14) KXCASE(15)
#undef KXCASE
            default: break;
        }
        }
        if (more) asm volatile("s_waitcnt vmcnt(4)" ::: "memory"); else asm volatile("s_waitcnt vmcnt(0)" ::: "memory");
        __syncthreads();
        cb = cb == 2 ? 0 : cb + 1;
    }
#undef ILOAD
    unsigned Tk = 0u;
    if (ng > 8) {
        unsigned kmax = 0u, kmn1 = 0xffffffffu;
#pragma unroll
        for (int gg = 0; gg < 16; ++gg) if (8 * gg < ng) {
#pragma unroll
            for (int k = 0; k < 8; ++k) { kmax = max(kmax, kx[8 * gg + k]); kmn1 = min(kmn1, kx[8 * gg + k] - 1u); } }
        kmax = xmax_u<32>(kmax); kmn1 = xmin_u<32>(kmn1);
        unsigned lo_k = kmn1 + 1u, hi_k = kmax + 1u;
        float dlo = (float)(32 * ng - 256) + 0.5f, dhi = 255.5f;
        int side = 0;
        bool done = false;
        if (hi_k - lo_k <= 1u) { Tk = lo_k; done = true; }
        for (int it = 0; it < 96; ++it) {
            const unsigned wd = hi_k - lo_k;
            const float frac = dlo * __builtin_amdgcn_rcpf(dlo + dhi);
            const float flo = __uint_as_float(keyinv(lo_k)), fhi = __uint_as_float(keyinv(min(hi_k, 0xff7fffffu)));
            unsigned Tt = wd < (1u << 23) ? lo_k + (unsigned)((float)wd * frac) : ordkey(flo + (fhi - flo) * frac);
            if (it >= 16) Tt = lo_k + (wd >> 1);
            Tt = min(max(Tt, lo_k + 1u), hi_k - 1u);
            if (done) Tt = Tk;
            int c4[4] = {0, 0, 0, 0};
#pragma unroll
            for (int gg = 0; gg < 16; ++gg) if (8 * gg < ng) {
#pragma unroll
                for (int k = 0; k < 8; ++k) c4[k & 3] += (kx[8 * gg + k] >= Tt) ? 1 : 0; }
            int cnt = (c4[0] + c4[1]) + (c4[2] + c4[3]);
            cnt = xsum_i<32>(cnt);
            if (!done) {
                if (cnt == 256) { Tk = Tt; done = true; }
                else if (cnt > 256) { lo_k = Tt; dlo = (float)(cnt - 256) + 0.5f; if (side == 1) dhi *= 0.5f; side = 1; }
                else { hi_k = Tt; dhi = (float)(256 - cnt) - 0.5f; if (side == 2) dlo *= 0.5f; side = 2; }
                if (!done && hi_k - lo_k <= 1u) { Tk = lo_k; done = true; }
            }
            if (__all(done)) break;
        }
    }
    unsigned wa0 = 0u, wa1 = 0u, wb0 = 0u, wb1 = 0u;
#pragma unroll
    for (int g = 0; g < 128; ++g) if (g < ng) {
        const unsigned long long bal = __ballot(kx[g] >= Tk);
        const unsigned lo = (unsigned)bal, hh = (unsigned)(bal >> 32);
        if (g < 64) { asm volatile("s_nop 1\n\tv_writelane_b32 %0, %1, %2" : "+v"(wa0) : "s"(lo), "n"(g & 63)); asm volatile("s_nop 1\n\tv_writelane_b32 %0, %1, %2" : "+v"(wa1) : "s"(hh), "n"(g & 63)); }
        else { asm volatile("s_nop 1\n\tv_writelane_b32 %0, %1, %2" : "+v"(wb0) : "s"(lo), "n"(g & 63)); asm volatile("s_nop 1\n\tv_writelane_b32 %0, %1, %2" : "+v"(wb1) : "s"(hh), "n"(g & 63)); }
    }
    unsigned* mr = MASK + (size_t)(m0 + 2 * wave) * 128;
    mr[lane] = wa0; mr[64 + lane] = wb0; mr[128 + lane] = wa1; mr[192 + lane] = wb1;
}

constexpr int NB_UNITS = NB * 8 * 16, NC_UNITS = NB * 4 * 16, NI_UNITS = NB * 256, P9_ITEMS = NB_UNITS + NC_UNITS, NA_UNITS = NB * 4 * 16;
__device__ __forceinline__ void attn_phase_all(Frame& F, KParams p, int qid, int l) {
    const float* gqa = p->in[I_GQA] + l * 128; const float* gqn = p->in[I_GQN] + l * 128; const float* gqr = p->in[I_GQR] + l * 64; const float* tab = (const float*)(p->ws + WS_TAB);
    const bf16* P = (const bf16*)(p->ws + WS_P); const bf16* QB = (const bf16*)(p->ws + WS_QB); const bf16* KVB = (const bf16*)(p->ws + WS_KVB); bf16* MIX = (bf16*)(p->ws + WS_H); const unsigned* MASK = (const unsigned*)(p->ws + WS_MASK);
    for (int it = q_next(F, qid); it < NB_UNITS + NC_UNITS + NA_UNITS; it = q_next(F, qid)) {
        const int lvl = it >> 7, r = it & 127, qb = 15 - lvl;
        if (r < 64) { const int b = r >> 3, h = r & 7; const size_t m0 = (size_t)b * SEQ + qb * 256, k0 = (size_t)b * SEQ;
            att::attn_unit<1>(QB + m0 * NQB + h * 192, NQB, KVB + k0 * NKVB + h * 256, KVB + k0 * NKVB + h * 256 + 128, NKVB, P + k0 * NP + PC_KR, MIX + m0 * DM + 512 + h * 128, DM, 4 * (qb + 1), qb * 256, nullptr, (char*)F.lds, F.wave, gqn, gqr, tab);
        } else if (r < 96) { const int bh = r - 64, b = bh >> 2, h = bh & 3; const size_t m0 = (size_t)b * SEQ + qb * 256, k0 = (size_t)b * SEQ;
            att::attn_unit<2>(P + m0 * NP + PC_QC + h * 128, NP, P + k0 * NP + PC_KC + h * 128, P + k0 * NP + PC_VC + h * 128, NP, nullptr, MIX + m0 * DM + 1536 + h * 128, DM, 4 * (qb + 1), qb * 256, nullptr, (char*)F.lds, F.wave);
        } else { const int bh = r - 96, b = bh >> 2, h = bh & 3; const size_t m0 = (size_t)b * SEQ + qb * 256, k0 = (size_t)b * SEQ;
            att::attn_unit<0>(P + m0 * NP + PC_QA + h * 128, NP, P + k0 * NP + PC_KA + h * 128, P + k0 * NP + PC_VA + h * 128, NP, nullptr, MIX + m0 * DM + h * 128, DM, 4 * (qb + 1), qb * 256, MASK + m0 * 128, (char*)F.lds, F.wave, gqa, nullptr, tab);
        }
    }
}
__device__ __forceinline__ void indexer_phase(Frame& F, KParams p, int qid) {
    for (int it = q_next(F, qid); it < NI_UNITS; it = q_next(F, qid)) { const int u16 = 255 - it / 8, b = it % 8; indexer_unit(p, b, u16, F.lds, F.tid); }
}

#ifndef FFN_SPLIT
#define FFN_SPLIT 1
#endif
constexpr int N_PHASES = 25 + 8 * (FFN_SPLIT - 1);
#ifndef WGM_RESID
#define WGM_RESID 4
#endif

__global__ void __launch_bounds__(NWAVES * 64, 2) mega_fwd(Params p_unused) {
    KParams p = (KParams)__builtin_amdgcn_kernarg_segment_ptr();
#ifndef CODE_SHIFT_NOPS
#define CODE_SHIFT_NOPS 28
#endif
    asm volatile(".rept %0\n\ts_nop 0\n\t.endr" :: "n"(CODE_SHIFT_NOPS));
    extern __shared__ __attribute__((aligned(16))) unsigned char lds_raw[];
    Frame F;
    F.lds = (LAS unsigned char*)lds_raw; F.MISC = (volatile LAS unsigned*)(F.lds + MISC_OFF);
    F.tid = threadIdx.x; F.lane = F.tid & 63; F.wave = __builtin_amdgcn_readfirstlane(F.tid >> 6); F.wave0 = F.wave;
    F.G = gridDim.x; { const int bx = blockIdx.x; F.vcu = (F.G % 8 == 0) ? (bx % 8) * (F.G / 8) + bx / 8 : bx; }
    F.ctl = (gu32*)(p->ws + WS_CTL);
    for (int u = F.tid; u < (LDS_BYTES - LDSCTL_OFF) / 4; u += NWAVES * 64) ((LAS unsigned*)(F.lds + LDSCTL_OFF))[u] = 0u;
    __syncthreads();
    const int lo = p->ph_lo, hi = p->ph_hi;
    XcdBarrier bar; bar.bar = (unsigned*)(F.ctl + CW_BAR); bar.x = 0; bar.st = nullptr;
    if (hi - lo > 1) bar = xcd_barrier_post((unsigned*)(F.ctl + CW_BAR), F.MISC + 8);
    int ph = 0;
#define RUN (relaunder(F), ({ asm volatile("" : "+s"(p)); 0; }), lo <= ph && ph < hi)
#define SEAM do { if (lo <= ph && ph + 1 < hi) { relaunder(F); xcd_barrier(bar, F.tid == 0); } ++ph; } while (0)
#define WSP(T, off) ((T*)(p->ws + (off)))
    if (RUN) p0_prologue(F, p);
    SEAM;
    for (int hl = 0; hl < 2 * NLAYER; ++hl) {
        const int l = hl >> 1, f = hl & 1;
#define MODL ((const float*)(p->ws + WS_MOD) + (size_t)l * NB * NMOD)
#define WL(off) ((const bf16*)(p->ws + WS_W + (size_t)l * LW_BYTES + (off)))
        if (f) {
            if (RUN) norm_phase(F, p->out, p->in[I_GMIX] + l * DM, MODL, 3, 4, WSP(bf16, WS_H));
            SEAM;
            if (RUN) { pg8::Gemm g{WSP(bf16, WS_H), WL(LW_IN), M, NP, DM, DM, DM}; pg8::StaticOrder S; S.init(M, NP, F.G, (int)blockIdx.x); pg8::EpiBf16 E{WSP(bf16, WS_P), NP};
                pg8::gemm_phase<pg8::EpiBf16, pg8::StaticOrder, true, true>(F.lds, g, S, E, F.wave); }
            SEAM;
            if (RUN) { post1_phase(F, p, l); indexer_phase(F, p, 1 + 2 * l); }
            SEAM;
            if (RUN) {
                { pg8::Gemm g{WSP(bf16, WS_P) + PC_CQ, WL(LW_UQ), M, NQB, 512, NP, 512}; pg8::StaticOrder S; S.init(M, NQB, F.G, (int)blockIdx.x); pg8::EpiBf16 E{WSP(bf16, WS_QB), NQB};
                  pg8::gemm_phase<pg8::EpiBf16, pg8::StaticOrder, true, true>(F.lds, g, S, E, F.wave); }
                relaunder(F); asm volatile("" : "+s"(p));
                { pg8::Gemm g{WSP(bf16, WS_P) + PC_CKV, WL(LW_UKV), M, NKVB, 128, NP, 128}; pg8::StaticOrder S; S.init(M, NKVB, F.G, (int)blockIdx.x); pg8::EpiKV E{WSP(bf16, WS_KVB), p->in[I_GKN] + l * 128, (LAS float*)(F.lds + RING_BYTES + 4096), NKVB};
                  pg8::gemm_phase<pg8::EpiKV, pg8::StaticOrder, true, true>(F.lds, g, S, E, F.wave); }
            }
            SEAM;
            if (RUN) attn_phase_all(F, p, 2 + 2 * l, l);
            SEAM;
            if (RUN) { pg8::Gemm g{WSP(bf16, WS_H), WL(LW_OUT), M, DM, DM, DM, DM}; pg8::StaticOrder S; S.init(M, DM, F.G, (int)blockIdx.x, WGM_RESID); pg8::EpiResid E{p->out, p->out, MODL + 5 * DM, 1.0f};
                pg8::gemm_phase<pg8::EpiResid, pg8::StaticOrder, true, true>(F.lds, g, S, E, F.wave); }
            SEAM;
        }
#define XIN ((hl == 0) ? p->in[I_X] : (const float*)p->out)
        if (RUN) norm_phase(F, XIN, p->in[f ? I_GFFN2 : I_GFFN1] + l * DM, MODL, f ? 6 : 0, f ? 7 : 1, WSP(bf16, WS_H));
        SEAM;
        for (int mh = 0; mh < FFN_SPLIT; ++mh) {
            constexpr int MS = M / FFN_SPLIT; const size_t r0 = (size_t)mh * MS;
            if (RUN) { pg8::Gemm g{WSP(bf16, WS_H) + r0 * DM, WL(f ? LW_GU2 : LW_GU1), MS, 2 * FF, DM, DM, DM}; pg8::StaticOrder S; S.init(MS, 2 * FF, F.G, (int)blockIdx.x); pg8::EpiSwiGLU E{WSP(bf16, WS_HID), FF};
                pg8::gemm_phase<pg8::EpiSwiGLU, pg8::StaticOrder, true, true>(F.lds, g, S, E, F.wave); }
            SEAM;
            if (RUN) { pg8::Gemm g{WSP(bf16, WS_HID), WL(f ? LW_DN2 : LW_DN1), MS, DM, FF, FF, FF}; pg8::StaticOrder S; S.init(MS, DM, F.G, (int)blockIdx.x, WGM_RESID, 1);
                pg8::EpiResid E{XIN + r0 * DM, p->out + r0 * DM, MODL + (f ? 8 : 2) * DM + (r0 / SEQ) * NMOD, 0.5f};
                pg8::gemm_phase<pg8::EpiResid, pg8::StaticOrder, true, true>(F.lds, g, S, E, F.wave); }
            SEAM;
        }
    }
#undef RUN
#undef SEAM
}

extern "C" void kernel_launch(void* const* d_in, const int* in_sizes, int n_in, void* d_out, int out_size, void* d_ws, size_t ws_size, hipStream_t stream) {
    static int grid = 0;
    if (grid == 0) {
        if (n_in != 25 || in_sizes[0] != M * DM || out_size != M * DM || ws_size < WS_END) { fprintf(stderr, "kernel_launch: shape mismatch: n_in %d in0 %d out %d ws %zu (need %zu)\n", n_in, n_in > 0 ? in_sizes[0] : -1, out_size, ws_size, (size_t)WS_END); grid = -1; return; }
        int dev = 0, cus = 0, per_cu = 0;
        if (hipGetDevice(&dev) != hipSuccess || hipDeviceGetAttribute(&cus, hipDeviceAttributeMultiprocessorCount, dev) != hipSuccess) { grid = -1; return; }
        if (hipFuncSetAttribute((const void*)mega_fwd, hipFuncAttributeMaxDynamicSharedMemorySize, LDS_BYTES) != hipSuccess) { fprintf(stderr, "kernel_launch: hipFuncSetAttribute failed\n"); grid = -1; return; }
        if (hipOccupancyMaxActiveBlocksPerMultiprocessor(&per_cu, (const void*)mega_fwd, NWAVES * 64, LDS_BYTES) != hipSuccess || per_cu < 1) fprintf(stderr, "kernel_launch: occupancy query reports %d blocks per CU\n", per_cu);
        (void)hipGetLastError();
        grid = cus;
    }
    if (grid < 0) return;
    if (hipMemsetAsync((char*)d_ws + WS_CTL, 0, CTL_ZERO_BYTES, stream) != hipSuccess) return;
    Params a{};
    for (int i = 0; i < 25; ++i) a.in[i] = (const float*)d_in[i];
    a.out = (float*)d_out; a.ws = (unsigned char*)d_ws;
    const int nph = N_PHASES < PH_STOP ? N_PHASES : PH_STOP;
#if MK_N_LAUNCHES == 1
    a.ph_lo = 0; a.ph_hi = nph;
    hipLaunchKernelGGL(mega_fwd, dim3(grid), dim3(NWAVES * 64), LDS_BYTES, stream, a);
#else
    for (int k = 0; k < nph; ++k) { a.ph_lo = k; a.ph_hi = k + 1; hipLaunchKernelGGL(mega_fwd, dim3(grid), dim3(NWAVES * 64), LDS_BYTES, stream, a); }
#endif
    const hipError_t le = hipPeekAtLastError();
    if (le != hipSuccess) fprintf(stderr, "kernel_launch: launch failed: %s\n", hipGetErrorName(le));
}
```
